# Optimizing an MI355X kernel written in HIP

```python
import jax, jax.numpy as jnp
from jax import lax
import numpy as np

D_MODEL = 2048
BATCH = 4
SEQ = 4096
DEPTH = 2

N_A = DEPTH // 2
N_B = DEPTH - N_A
GLA_HEADS = 4
GLA_DK = D_MODEL // 2 // GLA_HEADS
GLA_DV = D_MODEL // GLA_HEADS
GLA_QK = GLA_HEADS * GLA_DK
GLA_V = GLA_HEADS * GLA_DV
GLA_GATE_RANK = 16
GLA_TAU = 16.0
GLA_CHUNK = 64
MLA_HEADS = 16
MLA_NOPE = 128
MLA_ROPE = 64
MLA_V = 128
MLA_QK = MLA_NOPE + MLA_ROPE
Q_LORA = 512
KV_LORA = 512
ROPE_THETA = 10000.0
Q_BLOCK = 128
D_FF = -(-8 * D_MODEL // (3 * 256)) * 256
EPS = 1e-6

kernel_name = 'yoco_gla_mla_adaln_hybrid'


def rms_norm(x, gain):
    x32 = x.astype(jnp.float32)
    y = x32 * lax.rsqrt(jnp.mean(x32 * x32, axis=-1, keepdims=True) + EPS)
    return (y * gain.astype(jnp.float32)).astype(x.dtype)


def modulate(x, gain, shift, scale):
    return rms_norm(x, gain) * (1 + scale[:, None, :]) + shift[:, None, :]


def rope(x, cos, sin):
    half = MLA_ROPE // 2
    x32 = x.astype(jnp.float32)
    x1, x2 = x32[..., :half], x32[..., half:]
    return jnp.concatenate([x1 * cos - x2 * sin, x2 * cos + x1 * sin], axis=-1).astype(x.dtype)


def swiglu(h, w_gu, w_down):
    g, u = jnp.split(h @ w_gu, 2, axis=-1)
    return (jax.nn.silu(g) * u) @ w_down


def gla_mixer(h, w_in, w_alpha, b_alpha, onorm, w_out):
    B, S, _ = h.shape
    nc = S // GLA_CHUNK
    proj = h @ w_in
    q, k, v, g, a_lr = jnp.split(proj, [GLA_QK, 2 * GLA_QK, 2 * GLA_QK + GLA_V, 2 * GLA_QK + 2 * GLA_V], axis=-1)
    log_alpha = jax.nn.log_sigmoid((a_lr @ w_alpha + b_alpha).astype(jnp.float32)) / GLA_TAU

    def to_chunks(t, d):
        return t.astype(jnp.float32).reshape(B, nc, GLA_CHUNK, GLA_HEADS, d).transpose(1, 0, 3, 2, 4)

    qc = to_chunks(q, GLA_DK) * (GLA_DK ** -0.5)
    kc = to_chunks(k, GLA_DK)
    vc = to_chunks(v, GLA_DV)
    bcum = jnp.cumsum(to_chunks(log_alpha, GLA_DK), axis=3)
    b_last = bcum[:, :, :, -1:, :]
    q_dec = qc * jnp.exp(bcum)
    k_intra = kc * jnp.exp(-bcum)
    k_state = kc * jnp.exp(b_last - bcum)
    causal = jnp.tril(jnp.ones((GLA_CHUNK, GLA_CHUNK), dtype=bool))
    att = jnp.einsum('nbhik,nbhjk->nbhij', q_dec, k_intra)
    att = jnp.where(causal, att, 0.0)
    o_intra = jnp.einsum('nbhij,nbhjv->nbhiv', att, vc)

    def step(state, inp):
        q_n, k_n, v_n, dec_n = inp
        o_n = jnp.einsum('bhck,bhkv->bhcv', q_n, state)
        state = dec_n[..., None] * state + jnp.einsum('bhck,bhcv->bhkv', k_n, v_n)
        return state, o_n

    s0 = jnp.zeros((B, GLA_HEADS, GLA_DK, GLA_DV), jnp.float32)
    _, o_inter = lax.scan(step, s0, (q_dec, k_state, vc, jnp.exp(b_last[:, :, :, 0, :])))
    o = (o_intra + o_inter).transpose(1, 0, 3, 2, 4).reshape(B, S, GLA_HEADS, GLA_DV)
    o = rms_norm(o, onorm).astype(h.dtype)
    o = o * jax.nn.silu(g).reshape(B, S, GLA_HEADS, GLA_DV)
    return o.reshape(B, S, GLA_V) @ w_out


def shared_kv(x_mid, c, ada_w, ada_b, norm, w_dkv, lat_norm, w_ukv, k_norm, cos, sin):
    B, S, _ = x_mid.shape
    shift, scale = jnp.split(jax.nn.silu(c) @ ada_w + ada_b, 2, axis=-1)
    h = modulate(x_mid, norm, shift, scale)
    ckv = h @ w_dkv
    c_lat = rms_norm(ckv[..., :KV_LORA], lat_norm)
    k_pe = rope(ckv[..., KV_LORA:], cos, sin)
    kv = (c_lat @ w_ukv).reshape(B, S, MLA_HEADS, MLA_NOPE + MLA_V)
    k_nope, v = kv[..., :MLA_NOPE], kv[..., MLA_NOPE:]
    k = jnp.concatenate([k_nope, jnp.broadcast_to(k_pe[:, :, None, :], (B, S, MLA_HEADS, MLA_ROPE))], axis=-1)
    k = rms_norm(k, k_norm)
    return k, v


def mla_mixer(h, k, v, w_dq, q_lat_norm, w_uq, q_norm, w_out, cos, sin):
    B, S, _ = h.shape
    cq = rms_norm(h @ w_dq, q_lat_norm)
    q = (cq @ w_uq).reshape(B, S, MLA_HEADS, MLA_QK)
    q = jnp.concatenate([q[..., :MLA_NOPE], rope(q[..., MLA_NOPE:], cos[:, :, None, :], sin[:, :, None, :])], axis=-1)
    q = rms_norm(q, q_norm)
    nb = S // Q_BLOCK
    qb = q.reshape(B, nb, Q_BLOCK, MLA_HEADS, MLA_QK).transpose(1, 0, 2, 3, 4)
    key_idx = jnp.arange(S)
    sm_scale = MLA_QK ** -0.5

    def attend(args):
        q_blk, blk = args
        s = jnp.einsum('bqhd,bkhd->bhqk', q_blk, k).astype(jnp.float32) * sm_scale
        q_idx = blk * Q_BLOCK + jnp.arange(Q_BLOCK)
        s = jnp.where(key_idx[None, :] <= q_idx[:, None], s, -jnp.inf)
        p = jax.nn.softmax(s, axis=-1).astype(v.dtype)
        return jnp.einsum('bhqk,bkhd->bqhd', p, v)

    o = lax.map(attend, (qb, jnp.arange(nb)))
    o = o.transpose(1, 0, 2, 3, 4).reshape(B, S, MLA_HEADS * MLA_V)
    return o @ w_out


def setup_inputs(seed: int = 0) -> dict:
    key = jax.random.key(seed)
    ks = jax.random.split(key, 32)
    f32 = jnp.float32
    D = D_MODEL

    def nrm(k, shape, std):
        return jax.random.normal(k, shape, f32) * std

    def gain(k, shape):
        return 1.0 + 0.02 * jax.random.normal(k, shape, f32)

    offset = jax.random.randint(ks[2], (BATCH, 1), 0, 1024, dtype=jnp.int32)
    positions = offset + jnp.arange(SEQ, dtype=jnp.int32)[None, :]
    return {
        'x': nrm(ks[0], (BATCH, SEQ, D), 1.0),
        'c': nrm(ks[1], (BATCH, D), 1.0),
        'positions': positions,
        'ada_w': nrm(ks[3], (DEPTH, D, 6 * D), 0.5 * D ** -0.5),
        'ada_b': nrm(ks[4], (DEPTH, 6 * D), 0.01),
        'norm_mix': gain(ks[5], (DEPTH, D)),
        'norm_ffn': gain(ks[6], (DEPTH, D)),
        'gla_w_in': nrm(ks[7], (N_A, D, 2 * GLA_QK + 2 * GLA_V + GLA_GATE_RANK), D ** -0.5),
        'gla_w_alpha': nrm(ks[8], (N_A, GLA_GATE_RANK, GLA_QK), GLA_GATE_RANK ** -0.5),
        'gla_b_alpha': nrm(ks[9], (N_A, GLA_QK), 0.01),
        'gla_onorm': gain(ks[10], (N_A, GLA_DV)),
        'gla_w_out': nrm(ks[11], (N_A, GLA_V, D), GLA_V ** -0.5),
        'mla_w_dq': nrm(ks[12], (N_B, D, Q_LORA), D ** -0.5),
        'mla_q_lat_norm': gain(ks[13], (N_B, Q_LORA)),
        'mla_w_uq': nrm(ks[14], (N_B, Q_LORA, MLA_HEADS * MLA_QK), Q_LORA ** -0.5),
        'mla_q_norm': gain(ks[15], (N_B, MLA_QK)),
        'mla_w_out': nrm(ks[16], (N_B, MLA_HEADS * MLA_V, D), (MLA_HEADS * MLA_V) ** -0.5),
        'kv_ada_w': nrm(ks[17], (D, 2 * D), 0.5 * D ** -0.5),
        'kv_ada_b': nrm(ks[18], (2 * D,), 0.01),
        'kv_norm': gain(ks[19], (D,)),
        'kv_w_dkv': nrm(ks[20], (D, KV_LORA + MLA_ROPE), D ** -0.5),
        'kv_lat_norm': gain(ks[21], (KV_LORA,)),
        'kv_w_ukv': nrm(ks[22], (KV_LORA, MLA_HEADS * (MLA_NOPE + MLA_V)), KV_LORA ** -0.5),
        'kv_k_norm': gain(ks[23], (MLA_QK,)),
        'ffn_w_gu': nrm(ks[24], (DEPTH, D, 2 * D_FF), D ** -0.5),
        'ffn_w_down': nrm(ks[25], (DEPTH, D_FF, D), D_FF ** -0.5),
    }


def reference(x, c, positions, ada_w, ada_b, norm_mix, norm_ffn, gla_w_in, gla_w_alpha, gla_b_alpha,
              gla_onorm, gla_w_out, mla_w_dq, mla_q_lat_norm, mla_w_uq, mla_q_norm, mla_w_out,
              kv_ada_w, kv_ada_b, kv_norm, kv_w_dkv, kv_lat_norm, kv_w_ukv, kv_k_norm,
              ffn_w_gu, ffn_w_down):
    half = MLA_ROPE // 2
    inv_freq = ROPE_THETA ** (-jnp.arange(half, dtype=jnp.float32) / half)
    ang = positions.astype(jnp.float32)[..., None] * inv_freq
    cos, sin = jnp.cos(ang), jnp.sin(ang)
    k_sh, v_sh = None, None
    for layer in range(DEPTH):
        mod = jax.nn.silu(c) @ ada_w[layer] + ada_b[layer]
        shift_m, scale_m, gate_m, shift_f, scale_f, gate_f = jnp.split(mod, 6, axis=-1)
        if layer < N_A:
            h = modulate(x, norm_mix[layer], shift_m, scale_m)
            mix = gla_mixer(h, gla_w_in[layer], gla_w_alpha[layer], gla_b_alpha[layer],
                            gla_onorm[layer], gla_w_out[layer])
        else:
            j = layer - N_A
            if j == 0:
                k_sh, v_sh = shared_kv(x, c, kv_ada_w, kv_ada_b, kv_norm, kv_w_dkv, kv_lat_norm,
                                       kv_w_ukv, kv_k_norm, cos, sin)
            h = modulate(x, norm_mix[layer], shift_m, scale_m)
            mix = mla_mixer(h, k_sh, v_sh, mla_w_dq[j], mla_q_lat_norm[j], mla_w_uq[j],
                            mla_q_norm[j], mla_w_out[j], cos, sin)
        x = x + gate_m[:, None, :] * mix
        h = modulate(x, norm_ffn[layer], shift_f, scale_f)
        x = x + gate_f[:, None, :] * swiglu(h, ffn_w_gu[layer], ffn_w_down[layer])
    return x
```

```cpp
#include <hip/hip_runtime.h>
#include <hip/hip_cooperative_groups.h>
#include <cstdio>
#include <cstdint>
namespace cg = cooperative_groups;
namespace pg8 {
#define PG8_LAS __attribute__((address_space(3)))
typedef unsigned short bf16_t;
typedef short bf16x8 __attribute__((ext_vector_type(8)));
typedef float f32x4 __attribute__((ext_vector_type(4)));
typedef unsigned u32x4 __attribute__((ext_vector_type(4)));
constexpr int BM = 256, BK = 64, HALF = 128, HTB = HALF * BK * 2  , STAGE_BYTES = 8 * HTB, NXCD = 8, WGM = 8;

__host__ __device__ __forceinline__ int lds_byte(int r, int c) { const int st = (r >> 4) * 2 + (c >> 5), rr = r & 15, cc = c & 31, ob = rr * 64 + cc * 2; return st * 1024 + (ob ^ (((ob >> 9) & 1) << 5)); }
__host__ __device__ __forceinline__ void stage_rc(int b, int& R, int& C) { const int st = b / 1024, sb = b % 1024, swz = sb ^ (((sb >> 9) & 1) << 5); R = (st >> 1) * 16 + swz / 64; C = (st & 1) * 32 + (swz % 64) / 2; }
__host__ __device__ __forceinline__ int perm32(int rho) { const int n = rho >> 4, i = rho & 15; return 8 * (i >> 2) + 4 * n + (i & 3); }

struct Unit { int pm, pn; };
struct Gemm { const bf16_t* A; const bf16_t* Bt; int M, N, K; };

struct StaticOrder {
    int nM, nN, nwg, G, c;
    __host__ __device__ void init(int M, int N, int G_, int c_) { nM = M / BM; nN = N / BM; nwg = nM * nN; G = G_; c = c_; }
    __host__ __device__ bool next(int i, Unit& u) const {
        const long L = (long)i * G + c; if (L >= nwg) return false;
        int wgid = (int)L; { const int q = nwg / NXCD, r = nwg % NXCD, xcd = wgid % NXCD, off = wgid / NXCD; wgid = (xcd < r ? xcd * (q + 1) : r * (q + 1) + (xcd - r) * q) + off; }
        const int nig = WGM * nN, gid = wgid / nig, fm = gid * WGM, gsz = (nM - fm) < WGM ? (nM - fm) : WGM;
        u.pm = fm + ((wgid % nig) % gsz); u.pn = (wgid % nig) / gsz; return true;
    }
    __device__ __forceinline__ void a_ready(const Unit&) const {}
    __device__ __forceinline__ void done(const Unit&) const {}
};

__device__ __forceinline__ unsigned cvt_pk_bf16(float lo, float hi) { unsigned r; asm volatile("v_cvt_pk_bf16_f32 %0, %1, %2" : "=v"(r) : "v"(lo), "v"(hi)); return r; }
typedef float f32x2_t __attribute__((ext_vector_type(2))); typedef __bf16 bf16x2_t __attribute__((ext_vector_type(2)));
__device__ __forceinline__ unsigned cvtpk(float lo, float hi) { f32x2_t v = {lo, hi}; bf16x2_t b = __builtin_convertvector(v, bf16x2_t); return __builtin_bit_cast(unsigned, b); }
__device__ __forceinline__ float silu_f(float g) { return g * __builtin_amdgcn_rcpf(1.0f + __builtin_amdgcn_exp2f(-1.4426950408889634f * g)); }
struct EpiStoreBf16 {
    static constexpr bool PERM = true, AFTER_DRAIN = false;
    bf16_t* O; int ldc;
    __device__ __forceinline__ void operator()(const f32x4 (&acc)[2][2][4][2], const Unit& u, int wr, int wc, int fr, int fq) const {
        const int row0 = u.pm * BM + wr * 64 + fr, col0 = u.pn * BM + wc * 32 + 8 * fq;
#pragma unroll
        for (int ai = 0; ai < 2; ++ai)
#pragma unroll
            for (int m = 0; m < 4; ++m) { bf16_t* rowp = O + (size_t)(row0 + ai * HALF + m * 16) * ldc + col0;
#pragma unroll
                for (int bj = 0; bj < 2; ++bj) { const f32x4 v0 = acc[ai][bj][m][0], v1 = acc[ai][bj][m][1];
                    u32x4 w; w.x = cvtpk(v0[0], v0[1]); w.y = cvtpk(v0[2], v0[3]); w.z = cvtpk(v1[0], v1[1]); w.w = cvtpk(v1[2], v1[3]);
                    *(u32x4*)(rowp + bj * HALF) = w; } }
    }
};
__device__ __forceinline__ float row_rstd_ps(const float* ps, size_t grow) {
    const f32x4* p = (const f32x4*)(ps + grow * 32); f32x4 t = p[0];
#pragma unroll
    for (int i = 1; i < 8; ++i) t += p[i];
    return rsqrtf(((t[0] + t[1]) + (t[2] + t[3])) * (1.f / 2048.f) + 1e-6f);
}
struct EpiSwiglu {
    static constexpr bool PERM = true, AFTER_DRAIN = false;
    bf16_t* O; int ldc;
    __device__ __forceinline__ void operator()(const f32x4 (&acc)[2][2][4][2], const Unit& u, int wr, int wc, int fr, int fq) const {
        const int row0 = u.pm * BM + wr * 64 + fr, col0 = u.pn * HALF + wc * 32 + 8 * fq;
#pragma unroll
        for (int ai = 0; ai < 2; ++ai)
#pragma unroll
            for (int m = 0; m < 4; ++m) { bf16_t* rowp = O + (size_t)(row0 + ai * HALF + m * 16) * ldc + col0;
                const f32x4 g0 = acc[ai][0][m][0], g1 = acc[ai][0][m][1], u0 = acc[ai][1][m][0], u1 = acc[ai][1][m][1];
                u32x4 w; w.x = cvtpk(silu_f(g0[0]) * u0[0], silu_f(g0[1]) * u0[1]); w.y = cvtpk(silu_f(g0[2]) * u0[2], silu_f(g0[3]) * u0[3]);
                w.z = cvtpk(silu_f(g1[0]) * u1[0], silu_f(g1[1]) * u1[1]); w.w = cvtpk(silu_f(g1[2]) * u1[2], silu_f(g1[3]) * u1[3]);
                *(u32x4*)rowp = w; }
    }
};
struct EpiF32 {
    static constexpr bool PERM = false, AFTER_DRAIN = false;
    const float* base; float* out; int ldc; const float* gate; int gstride;
    __device__ __forceinline__ void operator()(const f32x4 (&acc)[2][2][4][2], const Unit& u, int wr, int wc, int fr, int fq) const {
        const int row0 = u.pm * BM + wr * 64 + fr, col0 = u.pn * BM + wc * 32 + 4 * fq, b = u.pm >> 4;
#pragma unroll
        for (int bj = 0; bj < 2; ++bj)
#pragma unroll
            for (int n = 0; n < 2; ++n) { const int col = col0 + bj * HALF + n * 16;
                const f32x4 gv = gate ? *(const f32x4*)(gate + (size_t)b * gstride + col) : (f32x4){1.f, 1.f, 1.f, 1.f};
#pragma unroll
                for (int ai = 0; ai < 2; ++ai)
#pragma unroll
                    for (int m = 0; m < 4; ++m) { const size_t off = (size_t)(row0 + ai * HALF + m * 16) * ldc + col;
                        f32x4 v = acc[ai][bj][m][n] * gv; if (base) v += *(const f32x4*)(base + off); *(f32x4*)(out + off) = v; } }
    }
};
struct OrderFold { StaticOrder o;
    __device__ bool next(int i, Unit& u) const { if (!o.next(i, u)) return false; u.pn += 5 * (u.pm >> 4); return true; }
    __device__ __forceinline__ void a_ready(const Unit&) const {}
    __device__ __forceinline__ void done(const Unit&) const {} };
struct EpiFold {
    static constexpr bool PERM = true, AFTER_DRAIN = false;
    bf16_t* ckv; bf16_t* cq; const float* bp; const float* rstdv;
    __device__ __forceinline__ void operator()(const f32x4 (&acc)[2][2][4][2], const Unit& u, int wr, int wc, int fr, int fq) const {
        const int b = u.pn / 5, j = u.pn - 5 * b, row0 = u.pm * BM + wr * 64 + fr, colt = wc * 32 + 8 * fq;
        bf16_t* out = j < 3 ? ckv : cq; const int ldc = j < 3 ? 768 : 512, cbase = j < 3 ? 256 * j : 256 * (j - 3);
        float rs[2][4];
#pragma unroll
        for (int ai = 0; ai < 2; ++ai)
#pragma unroll
            for (int m = 0; m < 4; ++m) rs[ai][m] = rstdv[(size_t)(row0 + ai * HALF + m * 16)];
#pragma unroll
        for (int bj = 0; bj < 2; ++bj) { const int cl = colt + bj * HALF; const float* bq = bp + (size_t)b * 1280 + 256 * j + cl;
            const f32x4 bias0 = (*(const f32x4*)bq + *(const f32x4*)(bq + 4 * 1280)) + (*(const f32x4*)(bq + 8 * 1280) + *(const f32x4*)(bq + 12 * 1280));
            const f32x4 bias1 = (*(const f32x4*)(bq + 4) + *(const f32x4*)(bq + 4 + 4 * 1280)) + (*(const f32x4*)(bq + 4 + 8 * 1280) + *(const f32x4*)(bq + 4 + 12 * 1280));
#pragma unroll
            for (int ai = 0; ai < 2; ++ai)
#pragma unroll
                for (int m = 0; m < 4; ++m) { const f32x4 v0 = acc[ai][bj][m][0] * rs[ai][m] + bias0, v1 = acc[ai][bj][m][1] * rs[ai][m] + bias1;
                    u32x4 w; w.x = cvtpk(v0[0], v0[1]); w.y = cvtpk(v0[2], v0[3]); w.z = cvtpk(v1[0], v1[1]); w.w = cvtpk(v1[2], v1[3]);
                    *(u32x4*)(out + (size_t)(row0 + ai * HALF + m * 16) * ldc + cbase + cl) = w; } }
    }
};
template <bool BASE_BF, bool OUT_BF> struct EpiRes {
    static constexpr bool PERM = true, AFTER_DRAIN = false;
    const void* base; void* out; const float* gate; float* ps;
    __device__ __forceinline__ void operator()(const f32x4 (&acc)[2][2][4][2], const Unit& u, int wr, int wc, int fr, int fq) const {
        const int row0 = u.pm * BM + wr * 64 + fr, col0 = u.pn * BM + wc * 32 + 8 * fq, b = u.pm >> 4;
        float ssq[2][4];
#pragma unroll
        for (int ai = 0; ai < 2; ++ai)
#pragma unroll
            for (int m = 0; m < 4; ++m) ssq[ai][m] = 0.f;
#pragma unroll
        for (int bj = 0; bj < 2; ++bj) { const int col = col0 + bj * HALF;
            const f32x4 g0 = *(const f32x4*)(gate + (size_t)b * 12288 + col), g1 = *(const f32x4*)(gate + (size_t)b * 12288 + col + 4);
#pragma unroll
            for (int ai = 0; ai < 2; ++ai)
#pragma unroll
                for (int m = 0; m < 4; ++m) { const size_t off = (size_t)(row0 + ai * HALF + m * 16) * 2048 + col;
                    f32x4 b0, b1;
                    if constexpr (BASE_BF) { const u32x4 w = *(const u32x4*)((const bf16_t*)base + off);
                        b0 = (f32x4){__uint_as_float(w.x << 16), __uint_as_float(w.x & 0xffff0000u), __uint_as_float(w.y << 16), __uint_as_float(w.y & 0xffff0000u)};
                        b1 = (f32x4){__uint_as_float(w.z << 16), __uint_as_float(w.z & 0xffff0000u), __uint_as_float(w.w << 16), __uint_as_float(w.w & 0xffff0000u)}; }
                    else { b0 = __builtin_nontemporal_load((const f32x4*)((const float*)base + off)); b1 = __builtin_nontemporal_load((const f32x4*)((const float*)base + off + 4)); }
                    const f32x4 v0 = acc[ai][bj][m][0] * g0 + b0, v1 = acc[ai][bj][m][1] * g1 + b1;
                    if constexpr (OUT_BF) { u32x4 w; w.x = cvtpk(v0[0], v0[1]); w.y = cvtpk(v0[2], v0[3]); w.z = cvtpk(v1[0], v1[1]); w.w = cvtpk(v1[2], v1[3]); *(u32x4*)((bf16_t*)out + off) = w;
                        const f32x4 r0 = (f32x4){__uint_as_float(w.x << 16), __uint_as_float(w.x & 0xffff0000u), __uint_as_float(w.y << 16), __uint_as_float(w.y & 0xffff0000u)},
                                    r1 = (f32x4){__uint_as_float(w.z << 16), __uint_as_float(w.z & 0xffff0000u), __uint_as_float(w.w << 16), __uint_as_float(w.w & 0xffff0000u)};
                        ssq[ai][m] += ((r0[0] * r0[0] + r0[1] * r0[1]) + (r0[2] * r0[2] + r0[3] * r0[3])) + ((r1[0] * r1[0] + r1[1] * r1[1]) + (r1[2] * r1[2] + r1[3] * r1[3])); }
                    else { *(f32x4*)((float*)out + off) = v0; *(f32x4*)((float*)out + off + 4) = v1; } } }
        if (ps) {
#pragma unroll
            for (int ai = 0; ai < 2; ++ai)
#pragma unroll
                for (int m = 0; m < 4; ++m) { float sq = ssq[ai][m]; sq += __shfl_xor(sq, 16); sq += __shfl_xor(sq, 32);
                    if (fq == 0) ps[(size_t)(row0 + ai * HALF + m * 16) * 32 + u.pn * 4 + wc] = sq; } }
    }
};
struct EpiKV {
    static constexpr bool PERM = true, AFTER_DRAIN = false;
    bf16_t* KN; bf16_t* VT; const float* KSS; const float* KPE; const float* knorm; PG8_LAS float* P;
    __device__ __forceinline__ void operator()(const f32x4 (&acc)[2][2][4][2], const Unit& u, int wr, int wc, int fr, int fq) const {
        const int h = u.pn, rl0 = wr * 64 + fr, grow0 = u.pm * BM + rl0;
#pragma unroll
        for (int ai = 0; ai < 2; ++ai)
#pragma unroll
            for (int m = 0; m < 4; ++m) { const f32x4 a = acc[ai][0][m][0], c = acc[ai][0][m][1];
                float s = (a[0] * a[0] + a[1] * a[1]) + (a[2] * a[2] + a[3] * a[3]) + (c[0] * c[0] + c[1] * c[1]) + (c[2] * c[2] + c[3] * c[3]);
                s += __shfl_xor(s, 16); s += __shfl_xor(s, 32);
                if (fq == 0) P[(ai * HALF + rl0 + m * 16) * 4 + wc] = s; }
        asm volatile("s_waitcnt lgkmcnt(0)" ::: "memory"); __builtin_amdgcn_s_barrier(); asm volatile("" ::: "memory");
        const f32x4 g0 = *(const f32x4*)(knorm + wc * 32 + 8 * fq), g1 = *(const f32x4*)(knorm + wc * 32 + 8 * fq + 4);
        const int pidx = 4 * (4 * wc + fq); const f32x4 gp = (f32x4){knorm[128 + (pidx >> 1)], knorm[160 + (pidx >> 1)], knorm[128 + (pidx >> 1) + 1], knorm[160 + (pidx >> 1) + 1]};
#pragma unroll
        for (int ai = 0; ai < 2; ++ai)
#pragma unroll
            for (int m = 0; m < 4; ++m) { const int rl = ai * HALF + rl0 + m * 16; const size_t grow = (size_t)(grow0 + ai * HALF + m * 16);
                const f32x4 ps = *(const PG8_LAS f32x4*)(P + rl * 4);
                const float rstd = rsqrtf(((ps[0] + ps[1]) + (ps[2] + ps[3]) + KSS[grow]) * (1.f / 192.f) + 1e-6f);
                const f32x4 a = acc[ai][0][m][0] * rstd * g0, c = acc[ai][0][m][1] * rstd * g1;
                u32x4 w; w.x = cvtpk(a[0], a[1]); w.y = cvtpk(a[2], a[3]); w.z = cvtpk(c[0], c[1]); w.w = cvtpk(c[2], c[3]);
                bf16_t* krow = KN + grow * 3072 + h * 192;
                *(u32x4*)(krow + wc * 32 + 8 * fq) = w;
                const f32x4 pe = *(const f32x4*)(KPE + grow * 64 + pidx) * rstd * gp;
                typedef unsigned u32x2_t __attribute__((ext_vector_type(2)));
                *(u32x2_t*)(krow + 128 + pidx) = (u32x2_t){cvtpk(pe[0], pe[1]), cvtpk(pe[2], pe[3])};
                const int b = (int)(grow >> 12), tok = (int)(grow & 4095);
                bf16_t* vcol = VT + ((size_t)((b * 16 + h) * 128 + wc * 32 + 8 * fq)) * 4096 + tok;
#pragma unroll
                for (int n = 0; n < 2; ++n)
#pragma unroll
                    for (int e = 0; e < 4; e += 2) { const unsigned pr = cvtpk(acc[ai][1][m][n][e], acc[ai][1][m][n][e + 1]);
                        vcol[(size_t)(4 * n + e) * 4096] = (bf16_t)(pr & 0xffffu); vcol[(size_t)(4 * n + e + 1) * 4096] = (bf16_t)(pr >> 16); } }
        asm volatile("s_waitcnt lgkmcnt(0)" ::: "memory"); __builtin_amdgcn_s_barrier(); asm volatile("" ::: "memory");
    }
};
struct EpiQ {
    static constexpr bool PERM = true, AFTER_DRAIN = false;
    bf16_t* QN; const float* CS; const float* qnorm; float qscale; PG8_LAS float* P;
    __device__ __forceinline__ void operator()(f32x4 (&acc)[2][2][4][2], const Unit& u, int wr, int wc, int fr, int fq) const {
        const int h = u.pn, rl0 = wr * 64 + fr, grow0 = u.pm * BM + rl0, pi0 = 16 * wc + 4 * fq;
#pragma unroll
        for (int ai = 0; ai < 2; ++ai)
#pragma unroll
            for (int m = 0; m < 4; ++m) {
                if (wc < 2) { const size_t grow = (size_t)(grow0 + ai * HALF + m * 16);
                    const f32x4 cv = *(const f32x4*)(CS + grow * 64 + pi0), sv = *(const f32x4*)(CS + grow * 64 + 32 + pi0);
#pragma unroll
                    for (int n = 0; n < 2; ++n) { f32x4 v = acc[ai][1][m][n];
                        const float c0 = cv[2 * n], s0 = sv[2 * n], c1 = cv[2 * n + 1], s1 = sv[2 * n + 1];
                        acc[ai][1][m][n] = (f32x4){v[0] * c0 - v[1] * s0, v[1] * c0 + v[0] * s0, v[2] * c1 - v[3] * s1, v[3] * c1 + v[2] * s1}; } }
                float s = 0.f;
#pragma unroll
                for (int bj = 0; bj < 2; ++bj)
#pragma unroll
                    for (int n = 0; n < 2; ++n) { const f32x4 a = acc[ai][bj][m][n]; s += (a[0] * a[0] + a[1] * a[1]) + (a[2] * a[2] + a[3] * a[3]); }
                s += __shfl_xor(s, 16); s += __shfl_xor(s, 32);
                if (fq == 0) P[(ai * HALF + rl0 + m * 16) * 4 + wc] = s; }
        asm volatile("s_waitcnt lgkmcnt(0)" ::: "memory"); __builtin_amdgcn_s_barrier(); asm volatile("" ::: "memory");
        const int c0n = wc * 32 + 8 * fq; const f32x4 g0 = *(const f32x4*)(qnorm + c0n), g1 = *(const f32x4*)(qnorm + c0n + 4);
        f32x4 r0 = {0.f, 0.f, 0.f, 0.f}, r1 = r0;
        if (wc < 2) { r0 = (f32x4){qnorm[128 + pi0], qnorm[160 + pi0], qnorm[128 + pi0 + 1], qnorm[160 + pi0 + 1]}; r1 = (f32x4){qnorm[128 + pi0 + 2], qnorm[160 + pi0 + 2], qnorm[128 + pi0 + 3], qnorm[160 + pi0 + 3]}; }
#pragma unroll
        for (int ai = 0; ai < 2; ++ai)
#pragma unroll
            for (int m = 0; m < 4; ++m) { const int rl = ai * HALF + rl0 + m * 16; const size_t grow = (size_t)(grow0 + ai * HALF + m * 16);
                const f32x4 ps = *(const PG8_LAS f32x4*)(P + rl * 4);
                const float rstd = rsqrtf(((ps[0] + ps[1]) + (ps[2] + ps[3])) * (1.f / 192.f) + 1e-6f) * qscale;
                bf16_t* qrow = QN + grow * 3072 + h * 192;
                { const f32x4 a = acc[ai][0][m][0] * rstd * g0, c = acc[ai][0][m][1] * rstd * g1;
                  u32x4 w; w.x = cvtpk(a[0], a[1]); w.y = cvtpk(a[2], a[3]); w.z = cvtpk(c[0], c[1]); w.w = cvtpk(c[2], c[3]);
                  *(u32x4*)(qrow + c0n) = w; }
                if (wc < 2) { const f32x4 a = acc[ai][1][m][0] * rstd * r0, c = acc[ai][1][m][1] * rstd * r1;
                  u32x4 w; w.x = cvtpk(a[0], a[1]); w.y = cvtpk(a[2], a[3]); w.z = cvtpk(c[0], c[1]); w.w = cvtpk(c[2], c[3]);
                  *(u32x4*)(qrow + 128 + c0n) = w; } }
        asm volatile("s_waitcnt lgkmcnt(0)" ::: "memory"); __builtin_amdgcn_s_barrier(); asm volatile("" ::: "memory");
    }
};
template <class Epi, class Sched, bool ALIGN_EPI = false, bool SP2 = false>
__device__ __forceinline__ void gemm_phase(PG8_LAS unsigned char* lds, const Gemm g, const Sched& S, const Epi& E) {
    int tid_o = threadIdx.x; asm volatile("" : "+v"(tid_o));
    const int tid = tid_o, wid = __builtin_amdgcn_readfirstlane(tid >> 6), lane = tid & 63, wr = wid >> 2, wc = wid & 3, fr = lane & 15, fq = lane >> 4;
    const int K = g.K, nt = K / BK;
    unsigned voffA[2], voffB[2];
#pragma unroll
    for (int i = 0; i < 2; ++i) { int R, C; stage_rc(tid * 16 + i * 8192, R, C); const int Rb = Epi::PERM ? ((R & ~31) + perm32(R & 31)) : R;
        voffA[i] = (unsigned)(R * K + C) * 2u; voffB[i] = (unsigned)(Rb * K + C) * 2u; }
    const size_t kstep = (size_t)(BK * 2);
    const size_t hstep = (size_t)HALF * K * 2;
    const size_t tstep = 2 * hstep;
    const unsigned ldsw = (unsigned)wid * 1024u;
    const int aoff = lds_byte(wr * 64 + fr, fq * 8), boff = lds_byte(wc * 32 + fr, fq * 8);
#define PG8_SA(b, h) (((b) * 2 + (h)) * HTB)
#define PG8_SB(b, h) ((4 + (b) * 2 + (h)) * HTB)
#define PG8_STAGE(bufoff, gbase, voff) do { _Pragma("unroll") for (int _i = 0; _i < 2; ++_i) \
        __builtin_amdgcn_global_load_lds((const unsigned*)((const char*)(gbase) + (voff)[_i]), (PG8_LAS unsigned*)(lds + (bufoff) + ldsw + _i * 8192), 16, 0, 0); } while (0)
#define PG8_LDA(dst, b, h) do { _Pragma("unroll") for (int m = 0; m < 4; ++m) _Pragma("unroll") for (int k = 0; k < 2; ++k) dst[m][k] = *(const PG8_LAS bf16x8*)(lds + PG8_SA(b, h) + aoff + m * 2048 + k * 1024); } while (0)
#define PG8_LDB(dst, b, h) do { _Pragma("unroll") for (int n = 0; n < 2; ++n) _Pragma("unroll") for (int k = 0; k < 2; ++k) dst[n][k] = *(const PG8_LAS bf16x8*)(lds + PG8_SB(b, h) + boff + n * 2048 + k * 1024); } while (0)
#define PG8_MMA(ai, bj, At, Bt) do { __builtin_amdgcn_s_setprio(1); _Pragma("unroll") for (int m = 0; m < 4; ++m) _Pragma("unroll") for (int n = 0; n < 2; ++n) _Pragma("unroll") for (int k = 0; k < 2; ++k) \
        acc[ai][bj][m][n] = __builtin_amdgcn_mfma_f32_16x16x32_bf16(Bt[n][k], At[m][k], acc[ai][bj][m][n], 0, 0, 0); __builtin_amdgcn_s_setprio(0); } while (0)
#define PG8_WAIT_V(n) asm volatile("s_waitcnt vmcnt(" #n ")" ::: "memory")
#define PG8_WAIT_L(n) asm volatile("s_waitcnt lgkmcnt(" #n ")" ::: "memory")
#define PG8_BAR __builtin_amdgcn_s_barrier()
#define PG8_SCHED __builtin_amdgcn_sched_barrier(0)
    Unit cur, nxt; int ui = 0;
    if (!S.next(0, cur)) return;
    f32x4 acc[2][2][4][2];
#pragma unroll
    for (int a = 0; a < 2; ++a)
#pragma unroll
        for (int b = 0; b < 2; ++b)
#pragma unroll
            for (int m = 0; m < 4; ++m)
#pragma unroll
                for (int n = 0; n < 2; ++n) acc[a][b][m][n] = (f32x4){0.f, 0.f, 0.f, 0.f};
    bf16x8 At[4][2], B0[2][2], B1[2][2];
    const char* cA = (const char*)g.A + (size_t)cur.pm * tstep; const char* cB = (const char*)g.Bt + (size_t)cur.pn * tstep;
    S.a_ready(cur);
    if constexpr (SP2) {
        PG8_STAGE(PG8_SB(0, 0), cB, voffB); PG8_STAGE(PG8_SB(0, 1), cB + hstep, voffB); PG8_STAGE(PG8_SA(0, 0), cA, voffA); PG8_STAGE(PG8_SA(0, 1), cA + hstep, voffA);
        if (wr == 1) PG8_BAR;
        PG8_WAIT_V(2); PG8_BAR;
        PG8_STAGE(PG8_SB(1, 0), cB + kstep, voffB); PG8_STAGE(PG8_SA(1, 0), cA + kstep, voffA); PG8_STAGE(PG8_SB(1, 1), cB + hstep + kstep, voffB);
        PG8_WAIT_V(6); PG8_BAR;
    } else {
        PG8_STAGE(PG8_SB(0, 0), cB, voffB); PG8_STAGE(PG8_SA(0, 0), cA, voffA); PG8_STAGE(PG8_SB(0, 1), cB + hstep, voffB); PG8_STAGE(PG8_SA(0, 1), cA + hstep, voffA);
        if (wr == 1) PG8_BAR;
        PG8_WAIT_V(4); PG8_BAR;
        PG8_STAGE(PG8_SB(1, 0), cB + kstep, voffB); PG8_STAGE(PG8_SA(1, 0), cA + kstep, voffA); PG8_STAGE(PG8_SB(1, 1), cB + hstep + kstep, voffB);
        PG8_WAIT_V(6); PG8_BAR;
    }
    for (;;) {
        const bool has_next = S.next(ui + 1, nxt);
        const char* nA = has_next ? (const char*)g.A + (size_t)nxt.pm * tstep : cA; const char* nB = has_next ? (const char*)g.Bt + (size_t)nxt.pn * tstep : cB;
        for (int t = 0; t < nt; t += 2) {
            const bool last = (t == nt - 2);
            const char* a1 = cA + (size_t)(t + 1) * kstep;
            const char* a2 = last ? nA : cA + (size_t)(t + 2) * kstep; const char* b2 = last ? nB : cB + (size_t)(t + 2) * kstep;
            const char* a3 = a2 + kstep; const char* b3 = b2 + kstep;
            if (last && has_next) S.a_ready(nxt);
            if constexpr (SP2) {
            PG8_LDB(B0, 0, 0); PG8_LDB(B1, 0, 1); PG8_SCHED; PG8_LDA(At, 0, 0); PG8_STAGE(PG8_SA(1, 1), a1 + hstep, voffA);
            PG8_WAIT_V(8); PG8_WAIT_L(0); PG8_BAR; PG8_MMA(0, 0, At, B0); PG8_MMA(0, 1, At, B1); PG8_BAR; PG8_SCHED;
            PG8_LDA(At, 0, 1); PG8_STAGE(PG8_SB(0, 0), b2, voffB); PG8_STAGE(PG8_SB(0, 1), b2 + hstep, voffB); PG8_STAGE(PG8_SA(0, 0), a2, voffA);
            PG8_WAIT_V(8); PG8_WAIT_L(0); PG8_BAR; PG8_MMA(1, 0, At, B0); PG8_MMA(1, 1, At, B1); PG8_BAR; PG8_SCHED;
            PG8_LDB(B0, 1, 0); PG8_LDB(B1, 1, 1); PG8_SCHED; PG8_LDA(At, 1, 0); PG8_STAGE(PG8_SA(0, 1), a2 + hstep, voffA);
            PG8_WAIT_V(8); PG8_WAIT_L(0); PG8_BAR; PG8_MMA(0, 0, At, B0); PG8_MMA(0, 1, At, B1); PG8_BAR; PG8_SCHED;
            PG8_LDA(At, 1, 1); PG8_STAGE(PG8_SB(1, 0), b3, voffB); PG8_STAGE(PG8_SB(1, 1), b3 + hstep, voffB); PG8_STAGE(PG8_SA(1, 0), a3, voffA);
            PG8_WAIT_V(8); PG8_WAIT_L(0); PG8_BAR; PG8_MMA(1, 0, At, B0); PG8_MMA(1, 1, At, B1); PG8_BAR; PG8_SCHED;
            } else {
            PG8_LDB(B0, 0, 0); PG8_SCHED; PG8_LDA(At, 0, 0); PG8_STAGE(PG8_SA(1, 1), a1 + hstep, voffA);
            PG8_WAIT_L(8); PG8_BAR; PG8_WAIT_L(0); PG8_MMA(0, 0, At, B0); PG8_BAR; PG8_SCHED;
            PG8_LDB(B1, 0, 1); PG8_STAGE(PG8_SB(0, 0), b2, voffB);
            PG8_BAR; PG8_WAIT_L(0); PG8_MMA(0, 1, At, B1); PG8_BAR;
            PG8_LDA(At, 0, 1); PG8_STAGE(PG8_SA(0, 0), a2, voffA);
            PG8_BAR; PG8_WAIT_L(0); PG8_MMA(1, 0, At, B0); PG8_BAR; PG8_SCHED;
            PG8_STAGE(PG8_SB(0, 1), b2 + hstep, voffB);
            PG8_WAIT_V(6); PG8_BAR; PG8_MMA(1, 1, At, B1); PG8_BAR;
            PG8_LDB(B0, 1, 0); PG8_SCHED; PG8_LDA(At, 1, 0); PG8_STAGE(PG8_SA(0, 1), a2 + hstep, voffA);
            PG8_WAIT_L(8); PG8_BAR; PG8_WAIT_L(0); PG8_MMA(0, 0, At, B0); PG8_BAR; PG8_SCHED;
            PG8_LDB(B1, 1, 1); PG8_STAGE(PG8_SB(1, 0), b3, voffB);
            PG8_BAR; PG8_WAIT_L(0); PG8_MMA(0, 1, At, B1); PG8_BAR;
            PG8_LDA(At, 1, 1); PG8_STAGE(PG8_SA(1, 0), a3, voffA);
            PG8_BAR; PG8_WAIT_L(0); PG8_MMA(1, 0, At, B0); PG8_BAR; PG8_SCHED;
            PG8_STAGE(PG8_SB(1, 1), b3 + hstep, voffB);
            PG8_WAIT_V(6); PG8_BAR; PG8_MMA(1, 1, At, B1); PG8_BAR;
            }
        }
        if constexpr (ALIGN_EPI) { if (wr == 0) PG8_BAR; }
        if constexpr (!Epi::AFTER_DRAIN) { E(acc, cur, wr, wc, fr, fq); S.done(cur); }
        if (!has_next) break;
#pragma unroll
        for (int a = 0; a < 2; ++a)
#pragma unroll
            for (int b = 0; b < 2; ++b)
#pragma unroll
                for (int m = 0; m < 4; ++m)
#pragma unroll
                    for (int n = 0; n < 2; ++n) acc[a][b][m][n] = (f32x4){0.f, 0.f, 0.f, 0.f};
        cur = nxt; cA = nA; cB = nB; ++ui;
        if constexpr (ALIGN_EPI) { if (wr == 1) PG8_BAR; }
    }
    PG8_WAIT_V(0);
    if constexpr (!ALIGN_EPI) { if (wr == 0) PG8_BAR; }
    PG8_BAR;
    if constexpr (Epi::AFTER_DRAIN) { E.fused(acc, cur, wr, wc, fr, fq, lds, wid, lane); S.done(cur); }
#undef PG8_SA
#undef PG8_SB
#undef PG8_STAGE
#undef PG8_LDA
#undef PG8_LDB
#undef PG8_MMA
#undef PG8_WAIT_V
#undef PG8_WAIT_L
#undef PG8_BAR
#undef PG8_SCHED
}
}
#define LAS __attribute__((address_space(3)))
typedef unsigned short bf16;
typedef unsigned v4u __attribute__((ext_vector_type(4)));
typedef unsigned v2u __attribute__((ext_vector_type(2)));
typedef float f32x4 __attribute__((ext_vector_type(4)));
typedef float f32x16 __attribute__((ext_vector_type(16)));
typedef short bf16x8 __attribute__((ext_vector_type(8)));
constexpr int NB = 4, SEQ = 4096, DM = 2048, M = NB * SEQ, DFF = 5632;
constexpr float EPS = 1e-6f;
constexpr size_t MiB = 1u << 20;
constexpr size_t WS_MOD = 1 * MiB, WS_ALR = 2 * MiB, WS_KPE = 3 * MiB, WS_KSS = 7 * MiB;
constexpr size_t WS_W_IN = 8 * MiB, WS_W_GOUT = 32 * MiB, WS_W_GU = 40 * MiB, WS_W_DN = 84 * MiB;
constexpr size_t WS_W_DKV = 8 * MiB  , WS_W_DQ = 8 * MiB, WS_W_UKV = 28 * MiB, WS_W_UQ = 32 * MiB, WS_W_MOUT = 704 * MiB, WS_BP = 7 * MiB + 256 * 1024, WS_PS = 730 * MiB  , WS_RSTD = 732 * MiB  ;
constexpr size_t WS_XR = 106 * MiB  , WS_C = 234 * MiB, WS_B = 298 * MiB, WS_A = 394 * MiB, WS_F = 586 * MiB, WS_END = 746 * MiB;
constexpr size_t WS_CKV = 586 * MiB, WS_CQ = 634 * MiB, WS_CLAT = 666 * MiB, WS_CQN = 682 * MiB, WS_KN = 394 * MiB, WS_VT = 490 * MiB, WS_CS = 700 * MiB;
constexpr int LDS_BYTES = 147456;
constexpr float QSCALE = 0.07216878364870322f * 1.4426950408889634f;
__device__ const double INVF[32] = {1, 0.74989420175552368, 0.56234133243560791, 0.42169651389122009, 0.31622776389122009, 0.23713737726211548, 0.17782793939113617, 0.13335214555263519,
    0.10000000149011612, 0.074989423155784607, 0.056234132498502731, 0.04216964915394783, 0.03162277489900589, 0.023713737726211548, 0.017782794311642647, 0.013335213996469975,
    0.0099999997764825821, 0.0074989423155784607, 0.0056234132498502731, 0.0042169648222625256, 0.0031622776295989752, 0.0023713738191872835, 0.0017782794311642647, 0.0013335214462131262,
    0.0010000000474974513, 0.00074989418499171734, 0.00056234130170196295, 0.0004216965171508491, 0.00031622775713913143, 0.00023713737027719617, 0.00017782794020604342, 0.00013335215044207871};

#define LDS_WAIT() asm volatile("s_waitcnt lgkmcnt(0)" ::: "memory")
__device__ __forceinline__ unsigned pk2(float lo, float hi) { return pg8::cvtpk(lo, hi); }
__device__ __forceinline__ float bflo(unsigned w) { return __uint_as_float(w << 16); }
__device__ __forceinline__ float bfhi(unsigned w) { return __uint_as_float(w & 0xffff0000u); }
__device__ __forceinline__ float bf2f(bf16 u) { return __uint_as_float((unsigned)u << 16); }
__device__ __forceinline__ float dot4(f32x4 a, f32x4 b) { return (a.x * b.x + a.y * b.y) + (a.z * b.z + a.w * b.w); }
__device__ __forceinline__ float wave_sum(float v) {
#pragma unroll
    for (int o = 1; o < 64; o <<= 1) v += __shfl_xor(v, o);
    return v;
}
__device__ __forceinline__ float silu(float g) { return pg8::silu_f(g); }

__device__ __forceinline__ void transpose_item(const float* W, int K, int Nsrc, int scol, bf16* WT, int drow, int k0, LAS float* scr, int lane, int rs = 1, const float* kgain = nullptr, const float* kscale = nullptr, bool ntst = false) {
    float tv[32];
#pragma unroll
    for (int i = 0; i < 32; ++i) tv[i] = __builtin_nontemporal_load(&W[(size_t)(k0 + 2 * i + (lane >> 5)) * Nsrc + scol + (lane & 31)]);
    if (kgain) {
#pragma unroll
        for (int i = 0; i < 32; ++i) { const int k = k0 + 2 * i + (lane >> 5); tv[i] *= kgain[k] * (1.f + kscale[k]); } }
#pragma unroll
    for (int i = 0; i < 32; ++i) scr[(2 * i + (lane >> 5)) * 33 + (lane & 31)] = tv[i];
    LDS_WAIT(); asm volatile("" ::: "memory");
    const int c = lane & 7;
#pragma unroll
    for (int j = 0; j < 4; ++j) { const int n = (lane >> 3) + 8 * j; const LAS float* s = scr + (8 * c) * 33 + n;
        v4u o; o.x = pk2(s[0 * 33], s[1 * 33]); o.y = pk2(s[2 * 33], s[3 * 33]); o.z = pk2(s[4 * 33], s[5 * 33]); o.w = pk2(s[6 * 33], s[7 * 33]);
        if (ntst) __builtin_nontemporal_store(o, (v4u*)(WT + (size_t)(drow + n * rs) * K + k0 + 8 * c)); else *(v4u*)(WT + (size_t)(drow + n * rs) * K + k0 + 8 * c) = o; }
    LDS_WAIT(); asm volatile("" ::: "memory");
}
__device__ __forceinline__ int gu_row(int c0) { const int s = c0 / DFF, rr = c0 % DFF; return 256 * (rr / 128) + 128 * s + (rr % 128); }

__device__ __forceinline__ void load_row(const float* xrow, int lane, f32x4 (&v)[8]) {
    const f32x4* xr = (const f32x4*)xrow + lane;
#pragma unroll
    for (int j = 0; j < 8; ++j) v[j] = __builtin_nontemporal_load(xr + 64 * j);
}
__device__ __forceinline__ float row_rstd(const f32x4 (&v)[8]) {
    float ss = 0.f;
#pragma unroll
    for (int j = 0; j < 8; ++j) ss += dot4(v[j], v[j]);
    return rsqrtf(wave_sum(ss) * (1.f / 2048.f) + EPS);
}
__device__ __forceinline__ void load_row_rstd(const float* xrow, int lane, f32x4 (&v)[8], float& rstd) {
    const f32x4* xr = (const f32x4*)xrow + lane; float ss = 0.f;
#pragma unroll
    for (int j = 0; j < 8; ++j) { v[j] = xr[64 * j]; ss += dot4(v[j], v[j]); }
    rstd = rsqrtf(wave_sum(ss) * (1.f / 2048.f) + EPS);
}
__device__ __forceinline__ void modulate_store(const f32x4 (&v)[8], float rstd, const float* gain, const float* shift, const float* scale, bf16* orow, int lane, f32x4 (&h)[8]) {
    const f32x4* g4 = (const f32x4*)gain + lane; const f32x4* sh4 = (const f32x4*)shift + lane; const f32x4* sc4 = (const f32x4*)scale + lane;
    unsigned long long* o8 = (unsigned long long*)orow + lane;
#pragma unroll
    for (int j = 0; j < 8; ++j) { h[j] = v[j] * rstd * g4[64 * j] * (1.f + sc4[64 * j]) + sh4[64 * j];
        o8[64 * j] = (unsigned long long)pk2(h[j].x, h[j].y) | ((unsigned long long)pk2(h[j].z, h[j].w) << 32); }
}


#define RLX_AGENT __ATOMIC_RELAXED, __HIP_MEMORY_SCOPE_AGENT
#define XB_TMO      128
#define XB_XCNT(j)  (256  + 64 * (j))
#define XB_XSUB(j)  (1280 + 64 * (j))
#define XB_XGEN(j)  (2304 + 64 * (j))
#define XB_TOP      3328
#define XB_TOPGEN   3392
#define XCD_BAR_WORDS 3456
#define XB_SPIN_CAP (1u << 18)

__device__ __forceinline__ unsigned xb_ld(unsigned* p)              { return __hip_atomic_load(p, __ATOMIC_RELAXED, __HIP_MEMORY_SCOPE_AGENT); }
__device__ __forceinline__ unsigned xb_add(unsigned* p, unsigned v) { return __hip_atomic_fetch_add(p, v, __ATOMIC_RELAXED, __HIP_MEMORY_SCOPE_AGENT); }
__device__ __forceinline__ unsigned xb_xcc_id() { return (unsigned)__builtin_amdgcn_s_getreg((3 << 11) | 20) & 0xFu; }
#define XB_SPIN(cond, bar) do { unsigned _sp = 0; while (cond) { __builtin_amdgcn_s_sleep(1); \
    if ((++_sp & 255u) == 0u) { if (xb_ld(&(bar)[XB_TMO])) break; if (_sp > XB_SPIN_CAP) { atomicAdd(&(bar)[XB_TMO], 1u); break; } } } } while (0)

struct XcdBarrier {
    unsigned* bar; unsigned x;
    volatile LAS unsigned* st;
};

__device__ __forceinline__ XcdBarrier xcd_barrier_post(unsigned* bar, volatile LAS unsigned* st) {
    XcdBarrier b; b.bar = bar; b.x = xb_xcc_id(); b.st = st;
    if (threadIdx.x == 0) (void)xb_add(&bar[XB_XCNT(b.x)], 1u);
    return b;
}
__device__ __forceinline__ void xcd_barrier_complete(unsigned* bar, unsigned x, unsigned& nloc, unsigned& nx) {
    const unsigned G = gridDim.x * gridDim.y * gridDim.z;
    unsigned sum, cnt, mine, sp = 0u;
    for (;;) {
        sum = 0u; cnt = 0u; mine = 0u;
#pragma unroll
        for (unsigned j = 0; j < 16; ++j) { const unsigned c = xb_ld(&bar[XB_XCNT(j)]); sum += c; cnt += (c > 0u) ? 1u : 0u; mine = (j == x) ? c : mine; }
        if (sum == G) break;
        __builtin_amdgcn_s_sleep(1);
        if ((++sp & 255u) == 0u) { if (xb_ld(&bar[XB_TMO])) break; if (sp > XB_SPIN_CAP) { atomicAdd(&bar[XB_TMO], 1u); break; } }
    }
    nloc = mine > 0u ? mine : 1u; nx = cnt > 0u ? cnt : 1u;
}

__device__ __forceinline__ void xcd_barrier(const XcdBarrier& b) {
    asm volatile("s_waitcnt vmcnt(0)" ::: "memory");
    __syncthreads();
    if (threadIdx.x == 0) {
        unsigned* bar = b.bar;
        __builtin_amdgcn_s_waitcnt(0);
        unsigned nloc = b.st[0], nx = b.st[1];
        if (nloc == 0u) { xcd_barrier_complete(bar, b.x, nloc, nx); b.st[0] = nloc; b.st[1] = nx; }
        const unsigned old = xb_add(&bar[XB_XSUB(b.x)], 1u);
        const unsigned gen = old / nloc;
        if (old + 1u == (gen + 1u) * nloc) {
            __builtin_amdgcn_fence(__ATOMIC_RELEASE, "agent");
            asm volatile("s_waitcnt vmcnt(0)" ::: "memory");
            const unsigned og = xb_add(&bar[XB_TOP], 1u);
            const unsigned tg = og / nx;
            if (og + 1u == (tg + 1u) * nx) xb_add(&bar[XB_TOPGEN], 1u);
            else XB_SPIN(xb_ld(&bar[XB_TOPGEN]) == tg, bar);
            __builtin_amdgcn_fence(__ATOMIC_ACQUIRE, "agent");
            xb_add(&bar[XB_XGEN(b.x)], 1u);
            asm volatile("s_waitcnt vmcnt(0)" ::: "memory");
        } else {
            XB_SPIN(xb_ld(&bar[XB_XGEN(b.x)]) == gen, bar);
            __builtin_amdgcn_fence(__ATOMIC_ACQUIRE, "agent");
            asm volatile("s_waitcnt vmcnt(0)" ::: "memory");
        }
    }
    __syncthreads();
}

__device__ __forceinline__ void load_row_bf(const bf16* xrow, int lane, f32x4 (&v)[8]) {
    const v2u* xr = (const v2u*)xrow + lane;
#pragma unroll
    for (int j = 0; j < 8; ++j) { const v2u w = xr[64 * j]; v[j] = (f32x4){bflo(w.x), bfhi(w.x), bflo(w.y), bfhi(w.y)}; }
}
template <typename TS> __device__ __forceinline__ void modulate_pair(const TS* src, int row, int lane, const float* gain1, const float* shift1, const float* scale1, bf16* out1,
                                              const float* gain2, const float* shift2, const float* scale2, bf16* out2) {
    f32x4 va[8], vb[8];
    if constexpr (sizeof(TS) == 4) { load_row((const float*)src + (size_t)row * DM, lane, va); load_row((const float*)src + (size_t)(row + 1) * DM, lane, vb); }
    else { load_row_bf((const bf16*)src + (size_t)row * DM, lane, va); load_row_bf((const bf16*)src + (size_t)(row + 1) * DM, lane, vb); }
    const float ra = row_rstd(va), rb = row_rstd(vb);
    { const f32x4* g4 = (const f32x4*)gain1 + lane; const f32x4* sh4 = (const f32x4*)shift1 + lane; const f32x4* sc4 = (const f32x4*)scale1 + lane;
      unsigned long long* oa = (unsigned long long*)(out1 + (size_t)row * DM) + lane; unsigned long long* ob = oa + DM / 4;
#pragma unroll
      for (int j = 0; j < 8; ++j) { const f32x4 g = g4[64 * j] * (1.f + sc4[64 * j]), sh = sh4[64 * j]; const f32x4 ha = va[j] * ra * g + sh, hb = vb[j] * rb * g + sh;
          oa[64 * j] = (unsigned long long)pk2(ha.x, ha.y) | ((unsigned long long)pk2(ha.z, ha.w) << 32); ob[64 * j] = (unsigned long long)pk2(hb.x, hb.y) | ((unsigned long long)pk2(hb.z, hb.w) << 32); } }
    if (out2) { const f32x4* g4 = (const f32x4*)gain2 + lane; const f32x4* sh4 = (const f32x4*)shift2 + lane; const f32x4* sc4 = (const f32x4*)scale2 + lane;
      unsigned long long* oa = (unsigned long long*)(out2 + (size_t)row * DM) + lane; unsigned long long* ob = oa + DM / 4;
#pragma unroll
      for (int j = 0; j < 8; ++j) { const f32x4 g = g4[64 * j] * (1.f + sc4[64 * j]), sh = sh4[64 * j]; const f32x4 ha = va[j] * ra * g + sh, hb = vb[j] * rb * g + sh;
          oa[64 * j] = (unsigned long long)pk2(ha.x, ha.y) | ((unsigned long long)pk2(ha.z, ha.w) << 32); ob[64 * j] = (unsigned long long)pk2(hb.x, hb.y) | ((unsigned long long)pk2(hb.z, hb.w) << 32); } }
}

#define MFMA32(a, b, c) __builtin_amdgcn_mfma_f32_32x32x16_bf16((a), (b), (c), 0, 0, 0)
constexpr int KT_PITCH = 400, VT_PITCH = 136, KT_BYTES = 64 * KT_PITCH, VT_BYTES = 128 * VT_PITCH, ATT_LDS = KT_BYTES + 2 * VT_BYTES;
__device__ __forceinline__ int crow(int r, int hi) { return (r & 3) + 8 * (r >> 2) + 4 * hi; }
__device__ __forceinline__ void attn_unit(int b, int h, int qb, const bf16* QN, const bf16* KN, const bf16* VT, bf16* AO, LAS unsigned char* lds, int tid) {
    const int lane = tid & 63, r32 = lane & 31, hi = lane >> 5; const int w = __builtin_amdgcn_readfirstlane(tid >> 6);
    const int q0 = qb * 256, NT = (q0 + 256) / 64;
    const bf16* qp = QN + ((size_t)(b * SEQ + q0 + 32 * w + r32)) * 3072 + h * 192 + 8 * hi;
    bf16x8 qf[12];
#pragma unroll
    for (int d0 = 0; d0 < 12; ++d0) qf[d0] = *(const bf16x8*)(qp + 16 * d0);
    f32x16 o[4];
#pragma unroll
    for (int dt = 0; dt < 4; ++dt)
#pragma unroll
        for (int i = 0; i < 16; ++i) o[dt][i] = 0.f;
    float m_run = -INFINITY, l_part = 0.f;
    const bf16* kbase = KN + ((size_t)(b * SEQ)) * 3072 + h * 192; const bf16* vbase = VT + ((size_t)((b * 16 + h) * 128)) * SEQ;
#define KSRC(i) ((((tl + 512 * (i)) / 24) * 3072) + 8 * ((tl + 512 * (i)) % 24))
#define KDST(i) ((((tl + 512 * (i)) / 24) * KT_PITCH) + 16 * ((tl + 512 * (i)) % 24))
#define VSRC(i) ((((tl + 512 * (i)) >> 3) * SEQ) + 8 * ((tl + 512 * (i)) & 7))
#define VDST(i) (KT_BYTES + (((tl + 512 * (i)) >> 3) * VT_PITCH) + 16 * ((tl + 512 * (i)) & 7))
    v4u kreg[3], vreg[2];
    int tl = tid; asm volatile("" : "+v"(tl));
#pragma unroll
    for (int i = 0; i < 3; ++i) kreg[i] = *(const v4u*)(kbase + KSRC(i));
#pragma unroll
    for (int i = 0; i < 2; ++i) vreg[i] = *(const v4u*)(vbase + VSRC(i));
#define PV_BLOCK(VB_) do { \
        const LAS unsigned char* vb0 = lds + KT_BYTES + (VB_) * VT_BYTES + r32 * VT_PITCH + (4 * hi) * 2; \
        v2u vl[2][4], vh[2][4]; \
        _Pragma("unroll") for (int dt = 0; dt < 4; ++dt) { vl[0][dt] = *(const LAS v2u*)(vb0 + dt * 32 * VT_PITCH); vh[0][dt] = *(const LAS v2u*)(vb0 + dt * 32 * VT_PITCH + 16); } \
        _Pragma("unroll") for (int cmb = 0; cmb < 4; ++cmb) { \
            const int u = cmb >> 1, s = cmb & 1; \
            if (cmb + 1 < 4) { const LAS unsigned char* vb = vb0 + (32 * ((cmb + 1) >> 1) + 16 * ((cmb + 1) & 1)) * 2; \
                _Pragma("unroll") for (int dt = 0; dt < 4; ++dt) { vl[(cmb + 1) & 1][dt] = *(const LAS v2u*)(vb + dt * 32 * VT_PITCH); vh[(cmb + 1) & 1][dt] = *(const LAS v2u*)(vb + dt * 32 * VT_PITCH + 16); } } \
            v4u pw; \
            if (u == 0) { pw.x = pk2(p0[8 * s], p0[8 * s + 1]); pw.y = pk2(p0[8 * s + 2], p0[8 * s + 3]); pw.z = pk2(p0[8 * s + 4], p0[8 * s + 5]); pw.w = pk2(p0[8 * s + 6], p0[8 * s + 7]); } \
            else        { pw.x = pk2(p1[8 * s], p1[8 * s + 1]); pw.y = pk2(p1[8 * s + 2], p1[8 * s + 3]); pw.z = pk2(p1[8 * s + 4], p1[8 * s + 5]); pw.w = pk2(p1[8 * s + 6], p1[8 * s + 7]); } \
            const bf16x8 pb = __builtin_bit_cast(bf16x8, pw); \
            __builtin_amdgcn_sched_barrier(0); \
            _Pragma("unroll") for (int dt = 0; dt < 4; ++dt) { const v4u av = (v4u){vl[cmb & 1][dt].x, vl[cmb & 1][dt].y, vh[cmb & 1][dt].x, vh[cmb & 1][dt].y}; \
                o[dt] = MFMA32(__builtin_bit_cast(bf16x8, av), pb, o[dt]); } \
            __builtin_amdgcn_sched_barrier(0); \
        } } while (0)
    f32x16 p0, p1; bool pend = false;
    for (int t = 0; t < NT; ++t) {
        __syncthreads();
        tl = tid; asm volatile("" : "+v"(tl));
#pragma unroll
        for (int i = 0; i < 3; ++i) *(LAS v4u*)(lds + KDST(i)) = kreg[i];
#pragma unroll
        for (int i = 0; i < 2; ++i) { LAS v2u* d = (LAS v2u*)(lds + (t & 1) * VT_BYTES + VDST(i)); d[0] = (v2u){vreg[i].x, vreg[i].y}; d[1] = (v2u){vreg[i].z, vreg[i].w}; }
        __syncthreads();
        if (t + 1 < NT) {
#pragma unroll
            for (int i = 0; i < 3; ++i) kreg[i] = *(const v4u*)(kbase + (size_t)(t + 1) * 64 * 3072 + KSRC(i));
#pragma unroll
            for (int i = 0; i < 2; ++i) vreg[i] = *(const v4u*)(vbase + (t + 1) * 64 + VSRC(i));
        }
        if (w >= 4 && pend) { PV_BLOCK((t - 1) & 1); pend = false; }
        const int jb = t - (NT - 4);
        if (jb >= 0 && 64 * jb > 32 * w + 31) continue;
#pragma unroll
        for (int i = 0; i < 16; ++i) { p0[i] = 0.f; p1[i] = 0.f; }
        const LAS unsigned char* kb = lds + r32 * KT_PITCH + hi * 16;
        bf16x8 ka[2][2];
        ka[0][0] = *(const LAS bf16x8*)(kb); ka[0][1] = *(const LAS bf16x8*)(kb + 32 * KT_PITCH);
#pragma unroll
        for (int d0 = 0; d0 < 12; ++d0) {
            if (d0 + 1 < 12) { ka[(d0 + 1) & 1][0] = *(const LAS bf16x8*)(kb + (d0 + 1) * 32); ka[(d0 + 1) & 1][1] = *(const LAS bf16x8*)(kb + 32 * KT_PITCH + (d0 + 1) * 32); }
            __builtin_amdgcn_sched_barrier(0);
            p0 = MFMA32(ka[d0 & 1][0], qf[d0], p0); p1 = MFMA32(ka[d0 & 1][1], qf[d0], p1);
            __builtin_amdgcn_sched_barrier(0);
        }
        if (jb >= 0) { const int qrel = 32 * w + r32;
#pragma unroll
            for (int i = 0; i < 16; ++i) { const int kv = 64 * jb + crow(i, hi); if (kv > qrel) p0[i] = -INFINITY; if (kv + 32 > qrel) p1[i] = -INFINITY; } }
        float mx = fmaxf(p0[0], p1[0]);
#pragma unroll
        for (int i = 1; i < 16; ++i) mx = fmaxf(mx, fmaxf(p0[i], p1[i]));
        { const auto rr = __builtin_amdgcn_permlane32_swap(__float_as_uint(mx), __float_as_uint(mx), false, false); mx = fmaxf(__uint_as_float(rr[0]), __uint_as_float(rr[1])); }
        const float m_new = fmaxf(m_run, mx), alpha = __builtin_amdgcn_exp2f(m_run - m_new); m_run = m_new;
        float rs = 0.f;
#pragma unroll
        for (int i = 0; i < 16; ++i) { p0[i] = __builtin_amdgcn_exp2f(p0[i] - m_new); p1[i] = __builtin_amdgcn_exp2f(p1[i] - m_new); rs += p0[i] + p1[i]; }
        l_part = l_part * alpha + rs;
        if (__builtin_amdgcn_ballot_w64(alpha != 1.0f) != 0ull) {
#pragma unroll
            for (int dt = 0; dt < 4; ++dt)
#pragma unroll
                for (int i = 0; i < 16; ++i) o[dt][i] *= alpha;
        }
        if (w < 4) PV_BLOCK(t & 1); else pend = true;
    }
    if (pend) PV_BLOCK((NT - 1) & 1);
#undef PV_BLOCK
    const float l = l_part + __shfl_xor(l_part, 32), inv = 1.f / l;
    bf16* op = AO + ((size_t)(b * SEQ + q0 + 32 * w + r32)) * 2048 + h * 128 + 4 * hi;
#pragma unroll
    for (int dt = 0; dt < 4; ++dt)
#pragma unroll
        for (int g = 0; g < 4; ++g) { v2u ov; ov.x = pk2(o[dt][4 * g] * inv, o[dt][4 * g + 1] * inv); ov.y = pk2(o[dt][4 * g + 2] * inv, o[dt][4 * g + 3] * inv);
            *(v2u*)(op + 32 * dt + 8 * g) = ov; }
}

struct Args { const void* in[26]; float* out; unsigned char* ws; };
typedef const __attribute__((address_space(4))) Args* ArgsP;
__global__ void __launch_bounds__(512, 2) fwd(Args a) {
    extern __shared__ __attribute__((aligned(16))) unsigned char lds_raw[];
    LAS unsigned char* lds = (LAS unsigned char*)lds_raw;
    cg::grid_group grid = cg::this_grid();
    const int G = gridDim.x, NGW = G * 8, NT = G * 512;
    const int vcu = (G % 8 == 0) ? (int)(blockIdx.x % 8) * (G / 8) + (int)(blockIdx.x / 8) : (int)blockIdx.x;
#define PV() ArgsP ap_ = (ArgsP)__builtin_amdgcn_kernarg_segment_ptr(); asm volatile("" : "+s"(ap_)); unsigned char* ws = ap_->ws; (void)ws; int tid_ = threadIdx.x; asm volatile("" : "+v"(tid_)); const int tid = tid_, lane = tid & 63, wave = __builtin_amdgcn_readfirstlane(tid >> 6), gw = blockIdx.x * 8 + wave, gt = blockIdx.x * 512 + tid; (void)lane; (void)gw; (void)gt; (void)wave
    unsigned* xbar_words = (unsigned*)a.ws;
    volatile LAS unsigned* xst = (volatile LAS unsigned*)(lds + LDS_BYTES - 64);
    if (threadIdx.x < 2) xst[threadIdx.x] = 0u;
    if (blockIdx.x == 0) for (int i = threadIdx.x; i < XCD_BAR_WORDS; i += 512) xbar_words[i] = 0u;
    __syncthreads();


    { PV(); const float* cvec = (const float*)ap_->in[1]; const float* ada_w = (const float*)ap_->in[3]; const float* ada_b = (const float*)ap_->in[4]; const float* kv_ada_w = (const float*)ap_->in[17]; const float* kv_ada_b = (const float*)ap_->in[18]; float* mod = (float*)(ws + WS_MOD); float* mod0 = mod; float* mod1 = mod + 49152; float* modkv = mod + 98304;
    {
        LAS float* sc = (LAS float*)lds; LAS float* red = (LAS float*)(lds + 32768);
        if (blockIdx.x < 224) for (int i = tid; i < 8192; i += 512) { const float v = cvec[i]; sc[i] = v / (1.f + __expf(-v)); }
        __syncthreads();
        for (int item = blockIdx.x; item < 224; item += G) {
            const int J0 = item * 128; const float* W; const float* bias; float* dst; int N;
            if (J0 < 12288) { W = ada_w + J0; bias = ada_b + J0; dst = mod0 + J0; N = 12288; }
            else if (J0 < 24576) { const int cc = J0 - 12288; W = ada_w + (size_t)2048 * 12288 + cc; bias = ada_b + 12288 + cc; dst = mod1 + cc; N = 12288; }
            else { const int cc = J0 - 24576; W = kv_ada_w + cc; bias = kv_ada_b + cc; dst = modkv + cc; N = 4096; }
            const int hw = tid >> 5, ln = tid & 31;
            const float* wp = W + (size_t)(hw * 128) * N + 4 * ln;
            f32x4 acc0 = {0.f, 0.f, 0.f, 0.f}, acc1 = acc0, acc2 = acc0, acc3 = acc0;
#pragma unroll 8
            for (int k = 0; k < 128; ++k) { const f32x4 wv = __builtin_nontemporal_load((const f32x4*)(wp + (size_t)k * N)); const int kk = hw * 128 + k;
                acc0 += sc[kk] * wv; acc1 += sc[2048 + kk] * wv; acc2 += sc[4096 + kk] * wv; acc3 += sc[6144 + kk] * wv; }
            *(LAS f32x4*)(red + (hw * 4 + 0) * 128 + 4 * ln) = acc0; *(LAS f32x4*)(red + (hw * 4 + 1) * 128 + 4 * ln) = acc1;
            *(LAS f32x4*)(red + (hw * 4 + 2) * 128 + 4 * ln) = acc2; *(LAS f32x4*)(red + (hw * 4 + 3) * 128 + 4 * ln) = acc3;
            __syncthreads();
            { const int b = tid >> 7, cc = tid & 127; float s = 0.f;
#pragma unroll
              for (int h2 = 0; h2 < 16; ++h2) s += red[(h2 * 4 + b) * 128 + cc];
              dst[(size_t)b * N + cc] = s + bias[cc]; }
            __syncthreads();
        }
    }
    }
    { PV(); const float* x = (const float*)ap_->in[0]; const float* gla_w_in = (const float*)ap_->in[7]; const float* gla_w_out = (const float*)ap_->in[11]; const float* ffn_w_gu = (const float*)ap_->in[24]; const float* ffn_w_down = (const float*)ap_->in[25]; float* ALR = (float*)(ws + WS_ALR); bf16* W_IN_T = (bf16*)(ws + WS_W_IN); bf16* W_GOUT_T = (bf16*)(ws + WS_W_GOUT); bf16* W_GU_T = (bf16*)(ws + WS_W_GU); bf16* W_DN_T = (bf16*)(ws + WS_W_DN); bf16* H = (bf16*)(ws + WS_C);
    {
        LAS float* scr = (LAS float*)(lds + wave * 16384);
        constexpr int I_IN = 32 * 192, I_GOUT = 32 * 64, I_GU = 32 * 352, I_DN = 88 * 64;
        for (int it = gw; it < I_IN + I_GOUT + I_GU + I_DN; it += NGW) {
            int r = it;
            if (r < I_IN) { const int kb = r / 192, nb = r % 192; transpose_item(gla_w_in, 2048, 6160, 32 * nb, W_IN_T, 32 * nb, 64 * kb, scr, lane); continue; } r -= I_IN;
            if (r < I_GOUT) { const int kb = r / 64, nb = r % 64; transpose_item(gla_w_out, 2048, 2048, 32 * nb, W_GOUT_T, 32 * nb, 64 * kb, scr, lane); continue; } r -= I_GOUT;
            if (r < I_GU) { const int kb = r / 352, nb = r % 352; transpose_item(ffn_w_gu, 2048, 2 * DFF, 32 * nb, W_GU_T, gu_row(32 * nb), 64 * kb, scr, lane); continue; } r -= I_GU;
            { const int kb = r / 64, nb = r % 64; transpose_item(ffn_w_down, DFF, 2048, 32 * nb, W_DN_T, 32 * nb, 64 * kb, scr, lane); }
        }
    }
    }
    grid.sync();
    XcdBarrier xb = xcd_barrier_post(xbar_words, xst);
    { PV(); const float* x = (const float*)ap_->in[0]; const float* norm_mix = (const float*)ap_->in[5]; const float* gla_w_in = (const float*)ap_->in[7]; float* mod = (float*)(ws + WS_MOD); float* mod0 = mod; float* ALR = (float*)(ws + WS_ALR); bf16* H = (bf16*)(ws + WS_C); bf16* PROJ = (bf16*)(ws + WS_A);
    {
        LAS float* wat = (LAS float*)lds;
        for (int i = tid; i < 32768; i += 512) { const int k = i >> 4, o = i & 15; wat[o * 2048 + k] = gla_w_in[(size_t)k * 6160 + 6144 + o]; }
        __syncthreads();
        f32x4 vn[8]; load_row(x + (size_t)gw * DM, lane, vn);
        for (int row = gw; row < M; row += NGW) {
            const int b = row >> 12; f32x4 v[8], h[8];
#pragma unroll
            for (int j = 0; j < 8; ++j) v[j] = vn[j];
            if (row + NGW < M) load_row(x + (size_t)(row + NGW) * DM, lane, vn);
            const float rstd = row_rstd(v);
            modulate_store(v, rstd, norm_mix, mod0 + (size_t)b * 12288, mod0 + (size_t)b * 12288 + 2048, H + (size_t)row * DM, lane, h);
#pragma unroll 1
            for (int og = 0; og < 2; ++og) {
                float a8[8];
#pragma unroll
                for (int oo = 0; oo < 8; ++oo) { float acc = 0.f;
#pragma unroll
                    for (int j = 0; j < 8; ++j) acc += dot4(h[j], *(const LAS f32x4*)(wat + (og * 8 + oo) * 2048 + 256 * j + 4 * lane));
                    a8[oo] = acc; if (oo & 1) __builtin_amdgcn_sched_barrier(0); }
                const bool b5 = (lane & 32) != 0, b4 = (lane & 16) != 0, b3 = (lane & 8) != 0;
                float a4[4], a2[2];
#pragma unroll
                for (int i = 0; i < 4; ++i) { const float keep = b5 ? a8[i + 4] : a8[i], send = b5 ? a8[i] : a8[i + 4]; a4[i] = keep + __shfl_xor(send, 32); }
#pragma unroll
                for (int i = 0; i < 2; ++i) { const float keep = b4 ? a4[i + 2] : a4[i], send = b4 ? a4[i] : a4[i + 2]; a2[i] = keep + __shfl_xor(send, 16); }
                float a1; { const float keep = b3 ? a2[1] : a2[0], send = b3 ? a2[0] : a2[1]; a1 = keep + __shfl_xor(send, 8); }
                a1 += __shfl_xor(a1, 4); a1 += __shfl_xor(a1, 2); a1 += __shfl_xor(a1, 1);
                if ((lane & 7) == 0) ALR[(size_t)row * 16 + og * 8 + 4 * ((lane >> 5) & 1) + 2 * ((lane >> 4) & 1) + ((lane >> 3) & 1)] = a1;
            }
        }
    }
    }
    xcd_barrier(xb);
#ifndef REP_P2
#define REP_P2 1
#endif
    for (int rep_ = 0; rep_ < REP_P2; ++rep_) {
    { PV(); bf16* W_IN_T = (bf16*)(ws + WS_W_IN); bf16* H = (bf16*)(ws + WS_C); bf16* PROJ = (bf16*)(ws + WS_A);
    { pg8::Gemm g{H, W_IN_T, M, 6144, 2048}; pg8::StaticOrder S; S.init(M, 6144, G, (int)blockIdx.x); pg8::EpiStoreBf16 E{PROJ, 6144};
      pg8::gemm_phase<pg8::EpiStoreBf16, pg8::StaticOrder, true, true>(lds, g, S, E); }
    }
    xcd_barrier(xb);
    }
#ifndef REP_GLA
#define REP_GLA 1
#endif
    for (int rep_ = 0; rep_ < REP_GLA; ++rep_) {
#ifndef REP_PREP
#define REP_PREP 1
#endif
    for (int rp_ = 0; rp_ < REP_PREP; ++rp_) {
    { PV(); const float* gla_w_alpha = (const float*)ap_->in[8]; const float* gla_b_alpha = (const float*)ap_->in[9]; float* ALR = (float*)(ws + WS_ALR); bf16* PROJ = (bf16*)(ws + WS_A);
        LAS float* alr_s = (LAS float*)lds; LAS float* tot_s = (LAS float*)(lds + 4096);
        LAS unsigned char* qd_s = lds + 8192; LAS unsigned char* ki_s = lds + 8192 + 33792; LAS unsigned char* v_s = lds + 8192 + 2 * 33792;
        const int dk = tid & 255, half = tid >> 8, l16 = lane & 15, quad = lane >> 4;
        for (int unit = blockIdx.x; unit < 1024; unit += G) {
            const int bh = unit >> 6, c = unit & 63, b = bh >> 2, h = bh & 3;
            const size_t row0 = (size_t)b * SEQ + c * 64; const size_t uc = (size_t)bh * 64 + c;
            { v4u qr[4], kr[4], vr[8];
              const bf16* qsrc = PROJ + (row0 + (tid >> 5)) * 6144 + h * 256 + 8 * (tid & 31);
#pragma unroll
              for (int i = 0; i < 4; ++i) { qr[i] = *(const v4u*)(qsrc + (size_t)i * 16 * 6144); kr[i] = *(const v4u*)(qsrc + (size_t)i * 16 * 6144 + 1024); }
              const bf16* vsrc = PROJ + (row0 + (tid >> 6)) * 6144 + 2048 + h * 512 + 8 * (tid & 63);
#pragma unroll
              for (int i = 0; i < 8; ++i) vr[i] = *(const v4u*)(vsrc + (size_t)i * 8 * 6144);
              if (tid < 256) *(LAS f32x4*)(alr_s + 4 * tid) = *(const f32x4*)(ALR + row0 * 16 + 4 * tid);
#pragma unroll
              for (int i = 0; i < 4; ++i) { *(LAS v4u*)(qd_s + ((tid >> 5) + 16 * i) * 528 + 16 * (tid & 31)) = qr[i]; *(LAS v4u*)(ki_s + ((tid >> 5) + 16 * i) * 528 + 16 * (tid & 31)) = kr[i]; }
#pragma unroll
              for (int i = 0; i < 8; ++i) *(LAS v4u*)(v_s + ((tid >> 6) + 8 * i) * 1040 + 16 * (tid & 63)) = vr[i]; }
            float wa[16];
#pragma unroll
            for (int r = 0; r < 16; ++r) wa[r] = gla_w_alpha[r * 1024 + h * 256 + dk];
            const float ba = gla_b_alpha[h * 256 + dk];
            __syncthreads();
            float bc[32]; float run = 0.f;
#pragma unroll
            for (int t = 0; t < 32; ++t) { const LAS f32x4* ar = (const LAS f32x4*)(alr_s + (half * 32 + t) * 16); float z = ba;
#pragma unroll
                for (int r4 = 0; r4 < 4; ++r4) { const f32x4 av = ar[r4]; z += av.x * wa[4 * r4] + av.y * wa[4 * r4 + 1] + av.z * wa[4 * r4 + 2] + av.w * wa[4 * r4 + 3]; }
                const float ls = fminf(z, 0.f) - __logf(1.f + __expf(-fabsf(z))); run += ls * 0.0625f; bc[t] = run; }
            tot_s[half * 256 + dk] = run;
            __syncthreads();
            const float bl = tot_s[dk] + tot_s[256 + dk], off = half ? tot_s[dk] : 0.f, ebl = __expf(bl);
            unsigned ksp[16];
#pragma unroll
            for (int t = 0; t < 32; ++t) { const float bct = bc[t] + off; LAS bf16* qe = (LAS bf16*)(qd_s + (half * 32 + t) * 528 + dk * 2); LAS bf16* ke = (LAS bf16*)(ki_s + (half * 32 + t) * 528 + dk * 2);
                const float q = bf2f(*qe), k = bf2f(*ke); const float e = __expf(bct), ki = k * __builtin_amdgcn_rcpf(e);
                const unsigned qd16 = pk2(q * 0.0625f * e, 0.f) & 0xffffu, ki16 = pk2(ki, 0.f) & 0xffffu, ks16 = pk2(ki * ebl, 0.f) & 0xffffu;
                *qe = (bf16)qd16; *ke = (bf16)ki16;
                if (t & 1) ksp[t >> 1] |= ks16 << 16; else ksp[t >> 1] = ks16; }
            { v4u* kd = (v4u*)((bf16*)(ws + WS_F + 32 * MiB) + (uc * 256 + dk) * 64 + half * 32);
#pragma unroll
              for (int i = 0; i < 4; ++i) kd[i] = (v4u){ksp[4 * i], ksp[4 * i + 1], ksp[4 * i + 2], ksp[4 * i + 3]}; }
            if (half == 0) ((float*)(ws + WS_F + 136 * MiB))[uc * 256 + dk] = ebl;
            __syncthreads();
            { const int ti = wave >> 1; bf16* attg = (bf16*)(ws + WS_F + 128 * MiB) + (uc * 64 + 16 * ti + l16) * 64 + 4 * quad;
#pragma unroll
              for (int tt = 0; tt < 2; ++tt) { const int tj = 2 * (wave & 1) + tt; f32x4 acc = {0.f, 0.f, 0.f, 0.f};
                  if (tj <= ti) {
#pragma unroll
                      for (int ks = 0; ks < 8; ++ks) { const bf16x8 ka = *(const LAS bf16x8*)(ki_s + (16 * tj + l16) * 528 + (32 * ks + 8 * quad) * 2), qb = *(const LAS bf16x8*)(qd_s + (16 * ti + l16) * 528 + (32 * ks + 8 * quad) * 2);
                          acc = __builtin_amdgcn_mfma_f32_16x16x32_bf16(ka, qb, acc, 0, 0, 0); }
                      const int ii = 16 * ti + l16, jj = 16 * tj + 4 * quad;
#pragma unroll
                      for (int e = 0; e < 4; ++e) if (jj + e > ii) acc[e] = 0.f; }
                  *(v2u*)(attg + 16 * tj) = (v2u){pk2(acc[0], acc[1]), pk2(acc[2], acc[3])}; } }
            { bf16* qdg = (bf16*)(ws + WS_F) + (uc * 64 + (tid >> 5)) * 256 + 8 * (tid & 31);
#pragma unroll
              for (int i = 0; i < 4; ++i) *(v4u*)(qdg + (size_t)i * 16 * 256) = *(const LAS v4u*)(qd_s + ((tid >> 5) + 16 * i) * 528 + 16 * (tid & 31)); }
            { unsigned vp[32];
#pragma unroll
              for (int t = 0; t < 64; ++t) { const unsigned val = *(const LAS bf16*)(v_s + t * 1040 + tid * 2); if (t & 1) vp[t >> 1] |= val << 16; else vp[t >> 1] = val; }
              v4u* vd = (v4u*)((bf16*)(ws + WS_F + 64 * MiB) + (uc * 512 + tid) * 64);
#pragma unroll
              for (int i = 0; i < 8; ++i) vd[i] = (v4u){vp[4 * i], vp[4 * i + 1], vp[4 * i + 2], vp[4 * i + 3]}; }
            __syncthreads();
        }
    }
    xcd_barrier(xb);
    }
    { PV(); bf16* H = (bf16*)(ws + WS_C); bf16* OG = H; bf16* GLAO = (bf16*)(ws + WS_B);
        const bf16* QD = (const bf16*)(ws + WS_F); const bf16* KST = (const bf16*)(ws + WS_F + 32 * MiB); const bf16* VTG = (const bf16*)(ws + WS_F + 64 * MiB);
        const bf16* ATT = (const bf16*)(ws + WS_F + 128 * MiB); const float* DEC = (const float*)(ws + WS_F + 136 * MiB);
        constexpr int SB_BYTES = 16896, QD_P = 528, AT_P = 144, STG_BYTES = 64 * QD_P + 64 * AT_P + 32 * AT_P, STG0 = 2 * SB_BYTES, O_ATT = 64 * QD_P, O_V = O_ATT + 64 * AT_P;
        const int l32 = lane & 31, hi = lane >> 5, l16 = lane & 15, quad = lane >> 4, ti = wave >> 1, tj = wave & 1;
        for (int item = vcu; item < 256; item += G) {
            const int bh = item >> 4, sl = item & 15, b = bh >> 2, h = bh & 3;
            f32x16 S;
#pragma unroll
            for (int i = 0; i < 16; ++i) S[i] = 0.f;
            const bf16* kst_w = KST + ((size_t)bh * 64 * 256 + 32 * wave + l32) * 64 + 8 * hi;
            const float* dec_w = DEC + (size_t)bh * 64 * 256 + 32 * wave + 4 * hi;
            bf16* o_out = GLAO + ((size_t)b * SEQ + 16 * ti + l16) * DM + h * 512 + 32 * sl + 16 * tj + 4 * quad;
            const bf16* qd_g = QD + (size_t)bh * 64 * 64 * 256 + (size_t)(tid >> 5) * 256 + 8 * (tid & 31);
            const bf16* at_g = ATT + (size_t)bh * 64 * 64 * 64 + (size_t)(tid >> 3) * 64 + 8 * (tid & 7);
            const bf16* vt_g = VTG + ((size_t)bh * 64 * 512 + 32 * sl + ((tid >> 3) & 31)) * 64 + 8 * (tid & 7);
            const int qd_l = (tid >> 5) * QD_P + 16 * (tid & 31), at_l = O_ATT + (tid >> 3) * AT_P + 16 * (tid & 7), vt_l = O_V + ((tid >> 3) & 31) * AT_P + 16 * (tid & 7);
            v4u sq[4], sa, sv; bf16x8 ka[4], kn[4]; f32x4 dc[4], dn[4];
#define GL_STAGE(c_) do { _Pragma("unroll") for (int i = 0; i < 4; ++i) sq[i] = *(const v4u*)(qd_g + (size_t)(c_) * 64 * 256 + i * 16 * 256); sa = *(const v4u*)(at_g + (size_t)(c_) * 4096); if (tid < 256) sv = *(const v4u*)(vt_g + (size_t)(c_) * 512 * 64); } while (0)
#define ST_STAGE(c_) do { LAS unsigned char* sg = lds + STG0 + ((c_) & 1) * STG_BYTES; _Pragma("unroll") for (int i = 0; i < 4; ++i) *(LAS v4u*)(sg + qd_l + i * 16 * QD_P) = sq[i]; *(LAS v4u*)(sg + at_l) = sa; if (tid < 256) *(LAS v4u*)(sg + vt_l) = sv; } while (0)
#define GL_KD(c_, K_, D_) do { _Pragma("unroll") for (int s2 = 0; s2 < 4; ++s2) { K_[s2] = *(const bf16x8*)(kst_w + (size_t)(c_) * 256 * 64 + 16 * s2); D_[s2] = *(const f32x4*)(dec_w + (c_) * 256 + 8 * s2); } } while (0)
            GL_STAGE(0); GL_KD(0, ka, dc);
            ST_STAGE(0);
            GL_STAGE(1);
#pragma unroll 1
            for (int c = 0; c < 64; ++c) {
                const int cn = (c + 1 < 64) ? c + 1 : c;
                GL_KD(cn, kn, dn);
                LAS unsigned char* sb = lds + (c & 1) * SB_BYTES; const LAS unsigned char* sg = lds + STG0 + (c & 1) * STG_BYTES;
#pragma unroll
                for (int g2 = 0; g2 < 4; ++g2) *(LAS v2u*)(sb + l32 * 528 + (32 * wave + 8 * g2 + 4 * hi) * 2) = (v2u){pk2(S[4 * g2], S[4 * g2 + 1]), pk2(S[4 * g2 + 2], S[4 * g2 + 3])};
                __syncthreads();
#pragma unroll
                for (int g2 = 0; g2 < 4; ++g2) { S[4 * g2] *= dc[g2].x; S[4 * g2 + 1] *= dc[g2].y; S[4 * g2 + 2] *= dc[g2].z; S[4 * g2 + 3] *= dc[g2].w; }
#pragma unroll
                for (int s2 = 0; s2 < 4; ++s2) { const bf16x8 vb = *(const LAS bf16x8*)(sg + O_V + l32 * AT_P + (16 * s2 + 8 * hi) * 2); S = MFMA32(ka[s2], vb, S); }
                f32x4 oa = {0.f, 0.f, 0.f, 0.f};
#pragma unroll
                for (int ks = 0; ks < 2; ++ks) { const bf16x8 va = *(const LAS bf16x8*)(sg + O_V + (16 * tj + l16) * AT_P + (32 * ks + 8 * quad) * 2), ab = *(const LAS bf16x8*)(sg + O_ATT + (16 * ti + l16) * AT_P + (32 * ks + 8 * quad) * 2);
                    oa = __builtin_amdgcn_mfma_f32_16x16x32_bf16(va, ab, oa, 0, 0, 0); }
#pragma unroll
                for (int ks = 0; ks < 8; ++ks) { const bf16x8 sa2 = *(const LAS bf16x8*)(sb + (16 * tj + l16) * 528 + (32 * ks + 8 * quad) * 2), qb = *(const LAS bf16x8*)(sg + (16 * ti + l16) * QD_P + (32 * ks + 8 * quad) * 2);
                    oa = __builtin_amdgcn_mfma_f32_16x16x32_bf16(sa2, qb, oa, 0, 0, 0); }
                *(v2u*)(o_out + (size_t)c * 64 * DM) = (v2u){pk2(oa[0], oa[1]), pk2(oa[2], oa[3])};
                if (c + 1 < 64) { ST_STAGE(c + 1); if (c + 2 < 64) GL_STAGE(c + 2); }
#pragma unroll
                for (int s2 = 0; s2 < 4; ++s2) { ka[s2] = kn[s2]; dc[s2] = dn[s2]; }
            }
            __syncthreads();
#undef GL_STAGE
#undef ST_STAGE
#undef GL_KD
        }
    }
    xcd_barrier(xb);
    }
#ifdef EXTRA_SYNCS
    for (int es_ = 0; es_ < EXTRA_SYNCS; ++es_) xcd_barrier(xb);
#endif
    { PV(); const float* x = (const float*)ap_->in[0]; const float* gla_onorm = (const float*)ap_->in[10]; float* XR = (float*)(ws + WS_XR); bf16* H = (bf16*)(ws + WS_C); bf16* OG = H; bf16* GLAO = (bf16*)(ws + WS_B); bf16* PROJ = (bf16*)(ws + WS_A);
    for (int row = gw; row < M; row += NGW) {
        const int hh = lane >> 4, l16 = lane & 15;
        const v4u* op = (const v4u*)(GLAO + (size_t)row * DM + hh * 512 + l16 * 32); const v4u* gp = (const v4u*)(PROJ + (size_t)row * 6144 + 4096 + hh * 512 + l16 * 32);
        v4u ov[4], gv[4]; float ss = 0.f;
#pragma unroll
        for (int i = 0; i < 4; ++i) { ov[i] = op[i]; gv[i] = gp[i]; }
#pragma unroll
        for (int i = 0; i < 4; ++i)
#pragma unroll
            for (int e = 0; e < 4; ++e) { const float lo = bflo(ov[i][e]), hi = bfhi(ov[i][e]); ss += lo * lo + hi * hi; }
        ss += __shfl_xor(ss, 1); ss += __shfl_xor(ss, 2); ss += __shfl_xor(ss, 4); ss += __shfl_xor(ss, 8);
        const float rstd = rsqrtf(ss * (1.f / 512.f) + EPS);
        const float* on = gla_onorm + l16 * 32; v4u* dst = (v4u*)(OG + (size_t)row * DM + hh * 512 + l16 * 32);
#pragma unroll
        for (int i = 0; i < 4; ++i) { v4u w;
#pragma unroll
            for (int e = 0; e < 4; ++e) { const int idx = i * 8 + e * 2;
                const float lo = bflo(ov[i][e]) * rstd * on[idx] * silu(bflo(gv[i][e])), hi = bfhi(ov[i][e]) * rstd * on[idx + 1] * silu(bfhi(gv[i][e]));
                w[e] = pk2(lo, hi); }
            dst[i] = w; }
    }
    }
    xcd_barrier(xb);
    { PV(); const float* x = (const float*)ap_->in[0]; const float* norm_ffn = (const float*)ap_->in[6]; float* mod = (float*)(ws + WS_MOD); float* mod0 = mod; bf16* W_GOUT_T = (bf16*)(ws + WS_W_GOUT); float* XR = (float*)(ws + WS_XR); bf16* H = (bf16*)(ws + WS_C); bf16* OG = H;
    { pg8::Gemm g{OG, W_GOUT_T, M, 2048, 2048}; pg8::StaticOrder S; S.init(M, 2048, G, (int)blockIdx.x); pg8::EpiRes<false, true> E{x, (bf16*)(ws + WS_XR), mod0 + 2 * 2048, nullptr};
      pg8::gemm_phase<pg8::EpiRes<false, true>, pg8::StaticOrder, true, true>(lds, g, S, E); }
    }
    xcd_barrier(xb);
    { PV(); const float* norm_ffn = (const float*)ap_->in[6]; float* mod = (float*)(ws + WS_MOD); float* mod0 = mod; float* XR = (float*)(ws + WS_XR); bf16* H = (bf16*)(ws + WS_C); bf16* PROJ = (bf16*)(ws + WS_A); bf16* ACT = PROJ;
    for (int row = 2 * gw; row < M; row += 2 * NGW) { const int b = row >> 12;
        modulate_pair((const bf16*)(ws + WS_XR), row, lane, norm_ffn, mod0 + (size_t)b * 12288 + 3 * 2048, mod0 + (size_t)b * 12288 + 4 * 2048, H, nullptr, nullptr, nullptr, nullptr); }
    }
    xcd_barrier(xb);
#ifndef REP_P7
#define REP_P7 1
#endif
    for (int rep_ = 0; rep_ < REP_P7; ++rep_) {
    { PV(); bf16* W_GU_T = (bf16*)(ws + WS_W_GU); float* XR = (float*)(ws + WS_XR); bf16* H = (bf16*)(ws + WS_C); bf16* PROJ = (bf16*)(ws + WS_A); bf16* ACT = PROJ;
    { pg8::Gemm g{H, W_GU_T, M, 2 * DFF, 2048}; pg8::StaticOrder S; S.init(M, 2 * DFF, G, (int)blockIdx.x); pg8::EpiSwiglu E{ACT, DFF};
      pg8::gemm_phase<pg8::EpiSwiglu, pg8::StaticOrder, true, true>(lds, g, S, E); }
    }
    xcd_barrier(xb);
    }
    { PV(); const float* norm_mix = (const float*)ap_->in[5]; const float* kv_norm = (const float*)ap_->in[19]; float* mod = (float*)(ws + WS_MOD); float* mod0 = mod; bf16* W_DN_T = (bf16*)(ws + WS_W_DN); float* XR = (float*)(ws + WS_XR); bf16* H = (bf16*)(ws + WS_C); bf16* GLAO = (bf16*)(ws + WS_B); bf16* HKV = GLAO; bf16* PROJ = (bf16*)(ws + WS_A); bf16* ACT = PROJ;
    { pg8::Gemm g{ACT, W_DN_T, M, 2048, DFF}; pg8::StaticOrder S; S.init(M, 2048, G, (int)blockIdx.x); pg8::EpiRes<true, true> E{(bf16*)(ws + WS_XR), (bf16*)(ws + WS_XR + 64 * MiB), mod0 + 5 * 2048, (float*)(ws + WS_PS)};
      pg8::gemm_phase<pg8::EpiRes<true, true>, pg8::StaticOrder, true, true>(lds, g, S, E); }
    }
    xcd_barrier(xb);
    { PV(); const float* norm_mix = (const float*)ap_->in[5]; const float* mla_w_dq = (const float*)ap_->in[12]; const float* mla_w_uq = (const float*)ap_->in[14]; const float* mla_w_out = (const float*)ap_->in[16]; const float* kv_norm = (const float*)ap_->in[19]; const float* kv_w_dkv = (const float*)ap_->in[20]; const float* kv_w_ukv = (const float*)ap_->in[22]; const float* ffn_w_gu = (const float*)ap_->in[24]; const float* ffn_w_down = (const float*)ap_->in[25]; float* mod = (float*)(ws + WS_MOD); float* mod1 = mod + 49152; float* modkv = mod + 98304; bf16* W_GU_T = (bf16*)(ws + WS_W_GU); bf16* W_DN_T = (bf16*)(ws + WS_W_DN); bf16* W_DKV_T = (bf16*)(ws + WS_W_DKV); bf16* W_DQ_T = (bf16*)(ws + WS_W_DQ); bf16* W_UKV_T = (bf16*)(ws + WS_W_UKV); bf16* W_UQ_T = (bf16*)(ws + WS_W_UQ); bf16* W_MOUT_T = (bf16*)(ws + WS_W_MOUT); float* XR = (float*)(ws + WS_XR); bf16* H = (bf16*)(ws + WS_C); bf16* GLAO = (bf16*)(ws + WS_B); bf16* HKV = GLAO; float* CKV = (float*)(ws + WS_CKV); float* CQ = (float*)(ws + WS_CQ);
    {
        for (int row = gt; row < M; row += NT) ((float*)(ws + WS_RSTD))[row] = pg8::row_rstd_ps((const float*)(ws + WS_PS), (size_t)row);
        __syncthreads();
        LAS float* scr = (LAS float*)(lds + wave * 16384);
        constexpr int I_DKV = 4 * 32 * 18, I_DQ = 4 * 32 * 16;
        for (int it = gw; it < I_DKV + I_DQ; it += NGW) {
            int r = it;
            if (r < I_DKV) { const int bb = r / 576, rr = r % 576, kb = rr / 18, nb = rr % 18;
                transpose_item(kv_w_dkv, 2048, 576, 32 * nb, W_DKV_T + (size_t)bb * 1280 * 2048, 32 * nb, 64 * kb, scr, lane, 1, kv_norm, modkv + (size_t)bb * 4096 + 2048); continue; } r -= I_DKV;
            { const int bb = r / 512, rr = r % 512, kb = rr / 16, nb = rr % 16;
                transpose_item(mla_w_dq, 2048, 512, 32 * nb, W_DKV_T + (size_t)bb * 1280 * 2048, 768 + 32 * nb, 64 * kb, scr, lane, 1, norm_mix + 2048, mod1 + (size_t)bb * 12288 + 2048); }
        }
        for (int i = gt; i < 4 * 49152; i += NT) { const int bb = i / 49152, off = i % 49152; ((v4u*)(W_DKV_T + ((size_t)bb * 1280 + 576) * 2048))[off] = (v4u){0u, 0u, 0u, 0u}; }
        { LAS float* red = (LAS float*)(lds + 131072); float* BP = (float*)(ws + WS_BP);
          for (int item = blockIdx.x; item < 136; item += G) { const int cg = item >> 2, kq = item & 3, c = tid & 31, ks = tid >> 5;
              const bool isk = cg < 18; const float* Wp = isk ? kv_w_dkv + 32 * cg + c : mla_w_dq + 32 * (cg - 18) + c; const int Nw = isk ? 576 : 512;
              const float* sh = isk ? modkv : mod1; const int shs = isk ? 4096 : 12288;
              float a0 = 0.f, a1 = 0.f, a2 = 0.f, a3 = 0.f;
#pragma unroll 8
              for (int kk = 0; kk < 32; ++kk) { const int k = 512 * kq + 32 * ks + kk; const float wv = Wp[(size_t)k * Nw];
                  a0 += sh[k] * wv; a1 += sh[shs + k] * wv; a2 += sh[2 * shs + k] * wv; a3 += sh[3 * shs + k] * wv; }
              __syncthreads();
              red[(ks * 4 + 0) * 32 + c] = a0; red[(ks * 4 + 1) * 32 + c] = a1; red[(ks * 4 + 2) * 32 + c] = a2; red[(ks * 4 + 3) * 32 + c] = a3;
              __syncthreads();
              if (tid < 128) { const int bb = tid >> 5; float sacc = 0.f;
#pragma unroll
                  for (int k2 = 0; k2 < 16; ++k2) sacc += red[(k2 * 4 + bb) * 32 + c];
                  BP[(size_t)(kq * 4 + bb) * 1280 + (isk ? 32 * cg : 768 + 32 * (cg - 18)) + c] = sacc; } } }
    }
    }
    xcd_barrier(xb);
    { PV(); float* KPE = (float*)(ws + WS_KPE); bf16* W_DKV_T = (bf16*)(ws + WS_W_DKV); bf16* W_DQ_T = (bf16*)(ws + WS_W_DQ); bf16* H = (bf16*)(ws + WS_C); bf16* GLAO = (bf16*)(ws + WS_B); bf16* HKV = GLAO; float* CKV = (float*)(ws + WS_CKV); float* CQ = (float*)(ws + WS_CQ); bf16* CLAT = (bf16*)(ws + WS_CLAT); bf16* CQN = (bf16*)(ws + WS_CQN);
    { pg8::Gemm g{(bf16*)(ws + WS_XR + 64 * MiB), W_DKV_T, M, 1280, 2048}; pg8::OrderFold S; S.o.init(M, 1280, G, (int)blockIdx.x); pg8::EpiFold E{(bf16*)CKV, (bf16*)CQ, (const float*)(ws + WS_BP), (const float*)(ws + WS_RSTD)};
      pg8::gemm_phase<pg8::EpiFold, pg8::OrderFold, true, true>(lds, g, S, E); }
    { const int nsingle = (G == 256) ? 192 : G, wi_ = (G == 256) ? (int)blockIdx.x - 64 : (int)blockIdx.x;
      if (wi_ >= 0) {
        const float* kv_w_ukv = (const float*)ap_->in[22]; const float* mla_w_uq = (const float*)ap_->in[14]; const float* mla_w_out = (const float*)ap_->in[16];
        const float* ffn_w_gu = (const float*)ap_->in[24]; const float* ffn_w_down = (const float*)ap_->in[25];
        bf16* W_UKV_T = (bf16*)(ws + WS_W_UKV); bf16* W_UQ_T = (bf16*)(ws + WS_W_UQ); bf16* W_MOUT_T = (bf16*)(ws + WS_W_MOUT); bf16* W_GU_T = (bf16*)(ws + WS_W_GU); bf16* W_DN_T = (bf16*)(ws + WS_W_DN);
        LAS float* scr = (LAS float*)(lds + wave * 16384);
        constexpr int I_UKV = 8 * 128, I_UQ = 8 * 96, I_MOUT = 32 * 64, I_GU = 32 * 352, I_DN = 88 * 64;
        for (int it = wi_ * 8 + wave; it < I_UKV + I_UQ + I_MOUT + I_GU + I_DN; it += nsingle * 8) {
            int r = it;
            if (r < I_UKV) { const int kb = r / 128, nb = r % 128; transpose_item(kv_w_ukv, 512, 4096, 32 * nb, W_UKV_T, 32 * nb, 64 * kb, scr, lane, 1, nullptr, nullptr, true); continue; } r -= I_UKV;
            if (r < I_UQ) { const int kb = r / 96, nb = r % 96, hq = nb / 6, wi = nb % 6;
                transpose_item(mla_w_uq, 512, 3072, 32 * nb, W_UQ_T, 256 * hq + (wi < 4 ? 32 * wi : 128 + (wi - 4)), 64 * kb, scr, lane, wi < 4 ? 1 : 2, nullptr, nullptr, true); continue; } r -= I_UQ;
            if (r < I_MOUT) { const int kb = r / 64, nb = r % 64; transpose_item(mla_w_out, 2048, 2048, 32 * nb, W_MOUT_T, 32 * nb, 64 * kb, scr, lane, 1, nullptr, nullptr, true); continue; } r -= I_MOUT;
            if (r < I_GU) { const int kb = r / 352, nb = r % 352; transpose_item(ffn_w_gu + (size_t)2048 * 2 * DFF, 2048, 2 * DFF, 32 * nb, W_GU_T, gu_row(32 * nb), 64 * kb, scr, lane, 1, nullptr, nullptr, true); continue; } r -= I_GU;
            { const int kb = r / 64, nb = r % 64; transpose_item(ffn_w_down + (size_t)DFF * 2048, DFF, 2048, 32 * nb, W_DN_T, 32 * nb, 64 * kb, scr, lane, 1, nullptr, nullptr, true); }
        }
        for (int i = wi_ * 512 + tid; i < 65536; i += nsingle * 512) { const int hq = i >> 12, off = i & 4095; ((v4u*)(W_UQ_T + ((size_t)hq * 256 + 192) * 512))[off] = (v4u){0u, 0u, 0u, 0u}; }
      } }
    }
    xcd_barrier(xb);
    { PV(); const int* positions = (const int*)ap_->in[2]; const float* mla_q_lat_norm = (const float*)ap_->in[13]; const float* kv_lat_norm = (const float*)ap_->in[21]; float* KPE = (float*)(ws + WS_KPE); float* KSS = (float*)(ws + WS_KSS); bf16* GLAO = (bf16*)(ws + WS_B); bf16* QRAW = GLAO; bf16* PROJ = (bf16*)(ws + WS_A); bf16* KVRAW = PROJ; float* CKV = (float*)(ws + WS_CKV); float* CQ = (float*)(ws + WS_CQ); bf16* CLAT = (bf16*)(ws + WS_CLAT); bf16* CQN = (bf16*)(ws + WS_CQN);
    for (int row = gw; row < M; row += NGW) {
        { const v4u cw = ((const v4u*)((const bf16*)CKV + (size_t)row * 768))[lane]; const f32x4 a0 = {bflo(cw.x), bfhi(cw.x), bflo(cw.y), bfhi(cw.y)}, a1 = {bflo(cw.z), bfhi(cw.z), bflo(cw.w), bfhi(cw.w)};
          const float rstd = rsqrtf(wave_sum(dot4(a0, a0) + dot4(a1, a1)) * (1.f / 512.f) + EPS);
          const f32x4* ln = (const f32x4*)kv_lat_norm + 2 * lane; const f32x4 g0 = ln[0], g1 = ln[1];
          v4u o; o.x = pk2(a0.x * rstd * g0.x, a0.y * rstd * g0.y); o.y = pk2(a0.z * rstd * g0.z, a0.w * rstd * g0.w); o.z = pk2(a1.x * rstd * g1.x, a1.y * rstd * g1.y); o.w = pk2(a1.z * rstd * g1.z, a1.w * rstd * g1.w);
          ((v4u*)(CLAT + (size_t)row * 512))[lane] = o; }
        { const int i = lane & 31; const float x1 = bf2f(((const bf16*)CKV)[(size_t)row * 768 + 512 + i]), x2 = bf2f(((const bf16*)CKV)[(size_t)row * 768 + 544 + i]);
          double rev = (double)((float)positions[row] * (float)INVF[i]) * 0.15915494309189535; rev -= rint(rev);
          const float c = __builtin_amdgcn_cosf((float)rev), s = __builtin_amdgcn_sinf((float)rev);
          const float o1 = x1 * c - x2 * s, o2 = x2 * c + x1 * s;
          if (lane < 32) { KPE[(size_t)row * 64 + 2 * i] = o1; KPE[(size_t)row * 64 + 2 * i + 1] = o2; float* CS = (float*)(ws + WS_CS); CS[(size_t)row * 64 + i] = c; CS[(size_t)row * 64 + 32 + i] = s; }
          const float ss = wave_sum(lane < 32 ? o1 * o1 + o2 * o2 : 0.f);
          if (lane == 0) KSS[row] = ss; }
        { const v4u cw = ((const v4u*)((const bf16*)CQ + (size_t)row * 512))[lane]; const f32x4 a0 = {bflo(cw.x), bfhi(cw.x), bflo(cw.y), bfhi(cw.y)}, a1 = {bflo(cw.z), bfhi(cw.z), bflo(cw.w), bfhi(cw.w)};
          const float rstd = rsqrtf(wave_sum(dot4(a0, a0) + dot4(a1, a1)) * (1.f / 512.f) + EPS);
          const f32x4* ln = (const f32x4*)mla_q_lat_norm + 2 * lane; const f32x4 g0 = ln[0], g1 = ln[1];
          v4u o; o.x = pk2(a0.x * rstd * g0.x, a0.y * rstd * g0.y); o.y = pk2(a0.z * rstd * g0.z, a0.w * rstd * g0.w); o.z = pk2(a1.x * rstd * g1.x, a1.y * rstd * g1.y); o.w = pk2(a1.z * rstd * g1.z, a1.w * rstd * g1.w);
          ((v4u*)(CQN + (size_t)row * 512))[lane] = o; }
    }
    }
    xcd_barrier(xb);
    { PV(); bf16* W_UKV_T = (bf16*)(ws + WS_W_UKV); bf16* W_UQ_T = (bf16*)(ws + WS_W_UQ); bf16* GLAO = (bf16*)(ws + WS_B); bf16* QRAW = GLAO; bf16* PROJ = (bf16*)(ws + WS_A); bf16* KVRAW = PROJ; bf16* CLAT = (bf16*)(ws + WS_CLAT); bf16* CQN = (bf16*)(ws + WS_CQN); bf16* KN = (bf16*)(ws + WS_KN); bf16* VT = (bf16*)(ws + WS_VT);
    { pg8::Gemm g{CLAT, W_UKV_T, M, 4096, 512}; pg8::StaticOrder S; S.init(M, 4096, G, (int)blockIdx.x);
      pg8::EpiKV E{KN, VT, (const float*)(ws + WS_KSS), (const float*)(ws + WS_KPE), (const float*)ap_->in[23], (LAS float*)(lds + 131072)};
      pg8::gemm_phase<pg8::EpiKV, pg8::StaticOrder, true, true>(lds, g, S, E); }
    { pg8::Gemm g{CQN, W_UQ_T, M, 4096, 512}; pg8::StaticOrder S; S.init(M, 4096, G, (int)blockIdx.x);
      pg8::EpiQ E{QRAW, (const float*)(ws + WS_CS), (const float*)ap_->in[15], QSCALE, (LAS float*)(lds + 131072)};
      pg8::gemm_phase<pg8::EpiQ, pg8::StaticOrder, true, true>(lds, g, S, E); }
    }
    xcd_barrier(xb);
#ifndef REP_ATTN
#define REP_ATTN 1
#endif
    for (int rep_ = 0; rep_ < REP_ATTN; ++rep_) {
    { PV(); const float* mla_w_out = (const float*)ap_->in[16]; float* XR = (float*)(ws + WS_XR); bf16* H = (bf16*)(ws + WS_C); bf16* AO = H; bf16* GLAO = (bf16*)(ws + WS_B); bf16* QRAW = GLAO; bf16* KN = (bf16*)(ws + WS_KN); bf16* VT = (bf16*)(ws + WS_VT);
    for (int pr = vcu; pr < 512; pr += G) {
        const int bh = pr >> 3, s = pr & 7, b = bh >> 4, h = bh & 15;
#pragma unroll 1
        for (int u2 = 0; u2 < 2; ++u2) attn_unit(b, h, u2 ? 15 - s : s, QRAW, KN, VT, AO, lds, tid);
    }
    }
    xcd_barrier(xb);
    }
    { PV(); const float* norm_ffn = (const float*)ap_->in[6]; float* mod = (float*)(ws + WS_MOD); float* mod1 = mod + 49152; bf16* W_MOUT_T = (bf16*)(ws + WS_W_MOUT); float* XR = (float*)(ws + WS_XR); bf16* H = (bf16*)(ws + WS_C); bf16* AO = H;
    { pg8::Gemm g{AO, W_MOUT_T, M, 2048, 2048}; pg8::StaticOrder S; S.init(M, 2048, G, (int)blockIdx.x); pg8::EpiRes<true, true> E{(bf16*)(ws + WS_XR + 64 * MiB), (bf16*)(ws + WS_XR), mod1 + 2 * 2048, nullptr};
      pg8::gemm_phase<pg8::EpiRes<true, true>, pg8::StaticOrder, true, true>(lds, g, S, E); }
    }
    xcd_barrier(xb);
    { PV(); const float* norm_ffn = (const float*)ap_->in[6]; float* mod = (float*)(ws + WS_MOD); float* mod1 = mod + 49152; float* XR = (float*)(ws + WS_XR); bf16* H = (bf16*)(ws + WS_C);
    for (int row = 2 * gw; row < M; row += 2 * NGW) { const int b = row >> 12;
        modulate_pair((const bf16*)(ws + WS_XR), row, lane, norm_ffn + 2048, mod1 + (size_t)b * 12288 + 3 * 2048, mod1 + (size_t)b * 12288 + 4 * 2048, H, nullptr, nullptr, nullptr, nullptr); }
    }
    xcd_barrier(xb);
    { PV(); float* mod = (float*)(ws + WS_MOD); float* mod1 = mod + 49152; bf16* W_GU_T = (bf16*)(ws + WS_W_GU); bf16* W_DN_T = (bf16*)(ws + WS_W_DN); float* XR = (float*)(ws + WS_XR); bf16* H = (bf16*)(ws + WS_C); bf16* PROJ = (bf16*)(ws + WS_A); bf16* ACT = PROJ;
    { pg8::Gemm g{H, W_GU_T, M, 2 * DFF, 2048}; pg8::StaticOrder S; S.init(M, 2 * DFF, G, (int)blockIdx.x); pg8::EpiSwiglu E{ACT, DFF};
      pg8::gemm_phase<pg8::EpiSwiglu, pg8::StaticOrder, true, true>(lds, g, S, E); }
    }
    xcd_barrier(xb);
    { PV(); float* mod = (float*)(ws + WS_MOD); float* mod1 = mod + 49152; bf16* W_DN_T = (bf16*)(ws + WS_W_DN); float* XR = (float*)(ws + WS_XR); bf16* ACT = (bf16*)(ws + WS_A);
    { pg8::Gemm g{ACT, W_DN_T, M, 2048, DFF}; pg8::StaticOrder S; S.init(M, 2048, G, (int)blockIdx.x); pg8::EpiRes<true, false> E{(bf16*)(ws + WS_XR), ap_->out, mod1 + 5 * 2048, nullptr};
      pg8::gemm_phase<pg8::EpiRes<true, false>, pg8::StaticOrder, true, true>(lds, g, S, E); }
    }
}

extern "C" void kernel_launch(void* const* d_in, const int* in_sizes, int n_in, void* d_out, int out_size, void* d_ws, size_t ws_size, hipStream_t stream) {
    static int grid = 0;
    if (grid == 0) {
        if (n_in != 26 || out_size != M * DM || ws_size < WS_END) { fprintf(stderr, "kernel_launch: unexpected shapes (n_in %d out %d ws %zu)\n", n_in, out_size, ws_size); grid = -1; return; }
        int dev = 0, cus = 0, per_cu = 0;
        (void)hipGetDevice(&dev); (void)hipDeviceGetAttribute(&cus, hipDeviceAttributeMultiprocessorCount, dev);
        (void)hipFuncSetAttribute((const void*)fwd, hipFuncAttributeMaxDynamicSharedMemorySize, LDS_BYTES);
        (void)hipOccupancyMaxActiveBlocksPerMultiprocessor(&per_cu, (const void*)fwd, 512, LDS_BYTES);
        if (per_cu < 1) per_cu = 1;
        grid = cus * per_cu;
    }
    if (grid < 0) return;
    Args a{};
    for (int i = 0; i < 26; ++i) a.in[i] = d_in[i];
    a.out = (float*)d_out; a.ws = (unsigned char*)d_ws;
    void* args[] = {&a};
    hipError_t e = hipLaunchCooperativeKernel((const void*)fwd, dim3(grid), dim3(512), args, LDS_BYTES, stream);
    if (e != hipSuccess) fprintf(stderr, "cooperative launch failed: %s (grid %d)\n", hipGetErrorString(e), grid);
}
```

```cpp
#include <hip/hip_runtime.h>
#include <hip/hip_cooperative_groups.h>
#include <cstdio>
#include <cstdint>
namespace cg = cooperative_groups;
namespace pg8 {
#define PG8_LAS __attribute__((address_space(3)))
typedef unsigned short bf16_t;
typedef short bf16x8 __attribute__((ext_vector_type(8)));
typedef float f32x4 __attribute__((ext_vector_type(4)));
typedef unsigned u32x4 __attribute__((ext_vector_type(4)));
constexpr int BM = 256, BK = 64, HALF = 128, HTB = HALF * BK * 2  , STAGE_BYTES = 8 * HTB, NXCD = 8, WGM = 8;

__host__ __device__ __forceinline__ int lds_byte(int r, int c) { const int st = (r >> 4) * 2 + (c >> 5), rr = r & 15, cc = c & 31, ob = rr * 64 + cc * 2; return st * 1024 + (ob ^ (((ob >> 9) & 1) << 5)); }
__host__ __device__ __forceinline__ void stage_rc(int b, int& R, int& C) { const int st = b / 1024, sb = b % 1024, swz = sb ^ (((sb >> 9) & 1) << 5); R = (st >> 1) * 16 + swz / 64; C = (st & 1) * 32 + (swz % 64) / 2; }
__host__ __device__ __forceinline__ int perm32(int rho) { const int n = rho >> 4, i = rho & 15; return 8 * (i >> 2) + 4 * n + (i & 3); }

struct Unit { int pm, pn; };
struct Gemm { const bf16_t* A; const bf16_t* Bt; int M, N, K; };

struct StaticOrder {
    int nM, nN, nwg, G, c;
    __host__ __device__ void init(int M, int N, int G_, int c_) { nM = M / BM; nN = N / BM; nwg = nM * nN; G = G_; c = c_; }
    __host__ __device__ bool next(int i, Unit& u) const {
        const long L = (long)i * G + c; if (L >= nwg) return false;
        int wgid = (int)L; { const int q = nwg / NXCD, r = nwg % NXCD, xcd = wgid % NXCD, off = wgid / NXCD; wgid = (xcd < r ? xcd * (q + 1) : r * (q + 1) + (xcd - r) * q) + off; }
        const int nig = WGM * nN, gid = wgid / nig, fm = gid * WGM, gsz = (nM - fm) < WGM ? (nM - fm) : WGM;
        u.pm = fm + ((wgid % nig) % gsz); u.pn = (wgid % nig) / gsz; return true;
    }
    __device__ __forceinline__ void a_ready(const Unit&) const {}
    __device__ __forceinline__ void done(const Unit&) const {}
};

__device__ __forceinline__ unsigned cvt_pk_bf16(float lo, float hi) { unsigned r; asm volatile("v_cvt_pk_bf16_f32 %0, %1, %2" : "=v"(r) : "v"(lo), "v"(hi)); return r; }
typedef float f32x2_t __attribute__((ext_vector_type(2))); typedef __bf16 bf16x2_t __attribute__((ext_vector_type(2)));
__device__ __forceinline__ unsigned cvtpk(float lo, float hi) { f32x2_t v = {lo, hi}; bf16x2_t b = __builtin_convertvector(v, bf16x2_t); return __builtin_bit_cast(unsigned, b); }
__device__ __forceinline__ float silu_f(float g) { return g * __builtin_amdgcn_rcpf(1.0f + __builtin_amdgcn_exp2f(-1.4426950408889634f * g)); }
struct EpiStoreBf16 {
    static constexpr bool PERM = true, AFTER_DRAIN = false;
    bf16_t* O; int ldc;
    __device__ __forceinline__ void operator()(const f32x4 (&acc)[2][2][4][2], const Unit& u, int wr, int wc, int fr, int fq) const {
        const int row0 = u.pm * BM + wr * 64 + fr, col0 = u.pn * BM + wc * 32 + 8 * fq;
#pragma unroll
        for (int ai = 0; ai < 2; ++ai)
#pragma unroll
            for (int m = 0; m < 4; ++m) { bf16_t* rowp = O + (size_t)(row0 + ai * HALF + m * 16) * ldc + col0;
#pragma unroll
                for (int bj = 0; bj < 2; ++bj) { const f32x4 v0 = acc[ai][bj][m][0], v1 = acc[ai][bj][m][1];
                    u32x4 w; w.x = cvtpk(v0[0], v0[1]); w.y = cvtpk(v0[2], v0[3]); w.z = cvtpk(v1[0], v1[1]); w.w = cvtpk(v1[2], v1[3]);
                    *(u32x4*)(rowp + bj * HALF) = w; } }
    }
};
__device__ __forceinline__ float row_rstd_ps(const float* ps, size_t grow) {
    const f32x4* p = (const f32x4*)(ps + grow * 32); f32x4 t = p[0];
#pragma unroll
    for (int i = 1; i < 8; ++i) t += p[i];
    return rsqrtf(((t[0] + t[1]) + (t[2] + t[3])) * (1.f / 2048.f) + 1e-6f);
}
struct EpiSwiglu {
    static constexpr bool PERM = true, AFTER_DRAIN = false;
    bf16_t* O; int ldc;
    __device__ __forceinline__ void operator()(const f32x4 (&acc)[2][2][4][2], const Unit& u, int wr, int wc, int fr, int fq) const {
        const int row0 = u.pm * BM + wr * 64 + fr, col0 = u.pn * HALF + wc * 32 + 8 * fq;
#pragma unroll
        for (int ai = 0; ai < 2; ++ai)
#pragma unroll
            for (int m = 0; m < 4; ++m) { bf16_t* rowp = O + (size_t)(row0 + ai * HALF + m * 16) * ldc + col0;
                const f32x4 g0 = acc[ai][0][m][0], g1 = acc[ai][0][m][1], u0 = acc[ai][1][m][0], u1 = acc[ai][1][m][1];
                u32x4 w; w.x = cvtpk(silu_f(g0[0]) * u0[0], silu_f(g0[1]) * u0[1]); w.y = cvtpk(silu_f(g0[2]) * u0[2], silu_f(g0[3]) * u0[3]);
                w.z = cvtpk(silu_f(g1[0]) * u1[0], silu_f(g1[1]) * u1[1]); w.w = cvtpk(silu_f(g1[2]) * u1[2], silu_f(g1[3]) * u1[3]);
                *(u32x4*)rowp = w; }
    }
};
struct EpiF32 {
    static constexpr bool PERM = false, AFTER_DRAIN = false;
    const float* base; float* out; int ldc; const float* gate; int gstride;
    __device__ __forceinline__ void operator()(const f32x4 (&acc)[2][2][4][2], const Unit& u, int wr, int wc, int fr, int fq) const {
        const int row0 = u.pm * BM + wr * 64 + fr, col0 = u.pn * BM + wc * 32 + 4 * fq, b = u.pm >> 4;
#pragma unroll
        for (int bj = 0; bj < 2; ++bj)
#pragma unroll
            for (int n = 0; n < 2; ++n) { const int col = col0 + bj * HALF + n * 16;
                const f32x4 gv = gate ? *(const f32x4*)(gate + (size_t)b * gstride + col) : (f32x4){1.f, 1.f, 1.f, 1.f};
#pragma unroll
                for (int ai = 0; ai < 2; ++ai)
#pragma unroll
                    for (int m = 0; m < 4; ++m) { const size_t off = (size_t)(row0 + ai * HALF + m * 16) * ldc + col;
                        f32x4 v = acc[ai][bj][m][n] * gv; if (base) v += *(const f32x4*)(base + off); *(f32x4*)(out + off) = v; } }
    }
};
struct OrderFold { StaticOrder o;
    __device__ bool next(int i, Unit& u) const { if (!o.next(i, u)) return false; u.pn += 5 * (u.pm >> 4); return true; }
    __device__ __forceinline__ void a_ready(const Unit&) const {}
    __device__ __forceinline__ void done(const Unit&) const {} };
struct EpiFold {
    static constexpr bool PERM = true, AFTER_DRAIN = false;
    bf16_t* ckv; bf16_t* cq; const float* bp; const float* rstdv;
    __device__ __forceinline__ void operator()(const f32x4 (&acc)[2][2][4][2], const Unit& u, int wr, int wc, int fr, int fq) const {
        const int b = u.pn / 5, j = u.pn - 5 * b, row0 = u.pm * BM + wr * 64 + fr, colt = wc * 32 + 8 * fq;
        bf16_t* out = j < 3 ? ckv : cq; const int ldc = j < 3 ? 768 : 512, cbase = j < 3 ? 256 * j : 256 * (j - 3);
        float rs[2][4];
#pragma unroll
        for (int ai = 0; ai < 2; ++ai)
#pragma unroll
            for (int m = 0; m < 4; ++m) rs[ai][m] = rstdv[(size_t)(row0 + ai * HALF + m * 16)];
#pragma unroll
        for (int bj = 0; bj < 2; ++bj) { const int cl = colt + bj * HALF; const float* bq = bp + (size_t)b * 1280 + 256 * j + cl;
            const f32x4 bias0 = (*(const f32x4*)bq + *(const f32x4*)(bq + 4 * 1280)) + (*(const f32x4*)(bq + 8 * 1280) + *(const f32x4*)(bq + 12 * 1280));
            const f32x4 bias1 = (*(const f32x4*)(bq + 4) + *(const f32x4*)(bq + 4 + 4 * 1280)) + (*(const f32x4*)(bq + 4 + 8 * 1280) + *(const f32x4*)(bq + 4 + 12 * 1280));
#pragma unroll
            for (int ai = 0; ai < 2; ++ai)
#pragma unroll
                for (int m = 0; m < 4; ++m) { const f32x4 v0 = acc[ai][bj][m][0] * rs[ai][m] + bias0, v1 = acc[ai][bj][m][1] * rs[ai][m] + bias1;
                    u32x4 w; w.x = cvtpk(v0[0], v0[1]); w.y = cvtpk(v0[2], v0[3]); w.z = cvtpk(v1[0], v1[1]); w.w = cvtpk(v1[2], v1[3]);
                    *(u32x4*)(out + (size_t)(row0 + ai * HALF + m * 16) * ldc + cbase + cl) = w; } }
    }
};
template <bool BASE_BF, bool OUT_BF> struct EpiRes {
    static constexpr bool PERM = true, AFTER_DRAIN = false;
    const void* base; void* out; const float* gate; float* ps;
    __device__ __forceinline__ void operator()(const f32x4 (&acc)[2][2][4][2], const Unit& u, int wr, int wc, int fr, int fq) const {
        const int row0 = u.pm * BM + wr * 64 + fr, col0 = u.pn * BM + wc * 32 + 8 * fq, b = u.pm >> 4;
        float ssq[2][4];
#pragma unroll
        for (int ai = 0; ai < 2; ++ai)
#pragma unroll
            for (int m = 0; m < 4; ++m) ssq[ai][m] = 0.f;
#pragma unroll
        for (int bj = 0; bj < 2; ++bj) { const int col = col0 + bj * HALF;
            const f32x4 g0 = *(const f32x4*)(gate + (size_t)b * 12288 + col), g1 = *(const f32x4*)(gate + (size_t)b * 12288 + col + 4);
#pragma unroll
            for (int ai = 0; ai < 2; ++ai)
#pragma unroll
                for (int m = 0; m < 4; ++m) { const size_t off = (size_t)(row0 + ai * HALF + m * 16) * 2048 + col;
                    f32x4 b0, b1;
                    if constexpr (BASE_BF) { const u32x4 w = *(const u32x4*)((const bf16_t*)base + off);
                        b0 = (f32x4){__uint_as_float(w.x << 16), __uint_as_float(w.x & 0xffff0000u), __uint_as_float(w.y << 16), __uint_as_float(w.y & 0xffff0000u)};
                        b1 = (f32x4){__uint_as_float(w.z << 16), __uint_as_float(w.z & 0xffff0000u), __uint_as_float(w.w << 16), __uint_as_float(w.w & 0xffff0000u)}; }
                    else { b0 = __builtin_nontemporal_load((const f32x4*)((const float*)base + off)); b1 = __builtin_nontemporal_load((const f32x4*)((const float*)base + off + 4)); }
                    const f32x4 v0 = acc[ai][bj][m][0] * g0 + b0, v1 = acc[ai][bj][m][1] * g1 + b1;
                    if constexpr (OUT_BF) { u32x4 w; w.x = cvtpk(v0[0], v0[1]); w.y = cvtpk(v0[2], v0[3]); w.z = cvtpk(v1[0], v1[1]); w.w = cvtpk(v1[2], v1[3]); *(u32x4*)((bf16_t*)out + off) = w;
                        const f32x4 r0 = (f32x4){__uint_as_float(w.x << 16), __uint_as_float(w.x & 0xffff0000u), __uint_as_float(w.y << 16), __uint_as_float(w.y & 0xffff0000u)},
                                    r1 = (f32x4){__uint_as_float(w.z << 16), __uint_as_float(w.z & 0xffff0000u), __uint_as_float(w.w << 16), __uint_as_float(w.w & 0xffff0000u)};
                        ssq[ai][m] += ((r0[0] * r0[0] + r0[1] * r0[1]) + (r0[2] * r0[2] + r0[3] * r0[3])) + ((r1[0] * r1[0] + r1[1] * r1[1]) + (r1[2] * r1[2] + r1[3] * r1[3])); }
                    else { *(f32x4*)((float*)out + off) = v0; *(f32x4*)((float*)out + off + 4) = v1; } } }
        if (ps) {
#pragma unroll
            for (int ai = 0; ai < 2; ++ai)
#pragma unroll
                for (int m = 0; m < 4; ++m) { float sq = ssq[ai][m]; sq += __shfl_xor(sq, 16); sq += __shfl_xor(sq, 32);
                    if (fq == 0) ps[(size_t)(row0 + ai * HALF + m * 16) * 32 + u.pn * 4 + wc] = sq; } }
    }
};
struct EpiKV {
    static constexpr bool PERM = true, AFTER_DRAIN = false;
    bf16_t* KN; bf16_t* VT; const float* KSS; const float* KPE; const float* knorm; PG8_LAS float* P;
    __device__ __forceinline__ void operator()(const f32x4 (&acc)[2][2][4][2], const Unit& u, int wr, int wc, int fr, int fq) const {
        const int h = u.pn, rl0 = wr * 64 + fr, grow0 = u.pm * BM + rl0;
#pragma unroll
        for (int ai = 0; ai < 2; ++ai)
#pragma unroll
            for (int m = 0; m < 4; ++m) { const f32x4 a = acc[ai][0][m][0], c = acc[ai][0][m][1];
                float s = (a[0] * a[0] + a[1] * a[1]) + (a[2] * a[2] + a[3] * a[3]) + (c[0] * c[0] + c[1] * c[1]) + (c[2] * c[2] + c[3] * c[3]);
                s += __shfl_xor(s, 16); s += __shfl_xor(s, 32);
                if (fq == 0) P[(ai * HALF + rl0 + m * 16) * 4 + wc] = s; }
        asm volatile("s_waitcnt lgkmcnt(0)" ::: "memory"); __builtin_amdgcn_s_barrier(); asm volatile("" ::: "memory");
        const f32x4 g0 = *(const f32x4*)(knorm + wc * 32 + 8 * fq), g1 = *(const f32x4*)(knorm + wc * 32 + 8 * fq + 4);
        const int pidx = 4 * (4 * wc + fq); const f32x4 gp = (f32x4){knorm[128 + (pidx >> 1)], knorm[160 + (pidx >> 1)], knorm[128 + (pidx >> 1) + 1], knorm[160 + (pidx >> 1) + 1]};
#pragma unroll
        for (int ai = 0; ai < 2; ++ai)
#pragma unroll
            for (int m = 0; m < 4; ++m) { const int rl = ai * HALF + rl0 + m * 16; const size_t grow = (size_t)(grow0 + ai * HALF + m * 16);
                const f32x4 ps = *(const PG8_LAS f32x4*)(P + rl * 4);
                const float rstd = rsqrtf(((ps[0] + ps[1]) + (ps[2] + ps[3]) + KSS[grow]) * (1.f / 192.f) + 1e-6f);
                const f32x4 a = acc[ai][0][m][0] * rstd * g0, c = acc[ai][0][m][1] * rstd * g1;
                u32x4 w; w.x = cvtpk(a[0], a[1]); w.y = cvtpk(a[2], a[3]); w.z = cvtpk(c[0], c[1]); w.w = cvtpk(c[2], c[3]);
                bf16_t* krow = KN + grow * 3072 + h * 192;
                *(u32x4*)(krow + wc * 32 + 8 * fq) = w;
                const f32x4 pe = *(const f32x4*)(KPE + grow * 64 + pidx) * rstd * gp;
                typedef unsigned u32x2_t __attribute__((ext_vector_type(2)));
                *(u32x2_t*)(krow + 128 + pidx) = (u32x2_t){cvtpk(pe[0], pe[1]), cvtpk(pe[2], pe[3])};
                const int b = (int)(grow >> 12), tok = (int)(grow & 4095);
                bf16_t* vcol = VT + ((size_t)((b * 16 + h) * 128 + wc * 32 + 8 * fq)) * 4096 + tok;
#pragma unroll
                for (int n = 0; n < 2; ++n)
#pragma unroll
                    for (int e = 0; e < 4; e += 2) { const unsigned pr = cvtpk(acc[ai][1][m][n][e], acc[ai][1][m][n][e + 1]);
                        vcol[(size_t)(4 * n + e) * 4096] = (bf16_t)(pr & 0xffffu); vcol[(size_t)(4 * n + e + 1) * 4096] = (bf16_t)(pr >> 16); } }
        asm volatile("s_waitcnt lgkmcnt(0)" ::: "memory"); __builtin_amdgcn_s_barrier(); asm volatile("" ::: "memory");
    }
};
struct EpiQ {
    static constexpr bool PERM = true, AFTER_DRAIN = false;
    bf16_t* QN; const float* CS; const float* qnorm; float qscale; PG8_LAS float* P;
    __device__ __forceinline__ void operator()(f32x4 (&acc)[2][2][4][2], const Unit& u, int wr, int wc, int fr, int fq) const {
        const int h = u.pn, rl0 = wr * 64 + fr, grow0 = u.pm * BM + rl0, pi0 = 16 * wc + 4 * fq;
#pragma unroll
        for (int ai = 0; ai < 2; ++ai)
#pragma unroll
            for (int m = 0; m < 4; ++m) {
                if (wc < 2) { const size_t grow = (size_t)(grow0 + ai * HALF + m * 16);
                    const f32x4 cv = *(const f32x4*)(CS + grow * 64 + pi0), sv = *(const f32x4*)(CS + grow * 64 + 32 + pi0);
#pragma unroll
                    for (int n = 0; n < 2; ++n) { f32x4 v = acc[ai][1][m][n];
                        const float c0 = cv[2 * n], s0 = sv[2 * n], c1 = cv[2 * n + 1], s1 = sv[2 * n + 1];
                        acc[ai][1][m][n] = (f32x4){v[0] * c0 - v[1] * s0, v[1] * c0 + v[0] * s0, v[2] * c1 - v[3] * s1, v[3] * c1 + v[2] * s1}; } }
                float s = 0.f;
#pragma unroll
                for (int bj = 0; bj < 2; ++bj)
#pragma unroll
                    for (int n = 0; n < 2; ++n) { const f32x4 a = acc[ai][bj][m][n]; s += (a[0] * a[0] + a[1] * a[1]) + (a[2] * a[2] + a[3] * a[3]); }
                s += __shfl_xor(s, 16); s += __shfl_xor(s, 32);
                if (fq == 0) P[(ai * HALF + rl0 + m * 16) * 4 + wc] = s; }
        asm volatile("s_waitcnt lgkmcnt(0)" ::: "memory"); __builtin_amdgcn_s_barrier(); asm volatile("" ::: "memory");
        const int c0n = wc * 32 + 8 * fq; const f32x4 g0 = *(const f32x4*)(qnorm + c0n), g1 = *(const f32x4*)(qnorm + c0n + 4);
        f32x4 r0 = {0.f, 0.f, 0.f, 0.f}, r1 = r0;
        if (wc < 2) { r0 = (f32x4){qnorm[128 + pi0], qnorm[160 + pi0], qnorm[128 + pi0 + 1], qnorm[160 + pi0 + 1]}; r1 = (f32x4){qnorm[128 + pi0 + 2], qnorm[160 + pi0 + 2], qnorm[128 + pi0 + 3], qnorm[160 + pi0 + 3]}; }
#pragma unroll
        for (int ai = 0; ai < 2; ++ai)
#pragma unroll
            for (int m = 0; m < 4; ++m) { const int rl = ai * HALF + rl0 + m * 16; const size_t grow = (size_t)(grow0 + ai * HALF + m * 16);
                const f32x4 ps = *(const PG8_LAS f32x4*)(P + rl * 4);
                const float rstd = rsqrtf(((ps[0] + ps[1]) + (ps[2] + ps[3])) * (1.f / 192.f) + 1e-6f) * qscale;
                bf16_t* qrow = QN + grow * 3072 + h * 192;
                { const f32x4 a = acc[ai][0][m][0] * rstd * g0, c = acc[ai][0][m][1] * rstd * g1;
                  u32x4 w; w.x = cvtpk(a[0], a[1]); w.y = cvtpk(a[2], a[3]); w.z = cvtpk(c[0], c[1]); w.w = cvtpk(c[2], c[3]);
                  *(u32x4*)(qrow + c0n) = w; }
                if (wc < 2) { const f32x4 a = acc[ai][1][m][0] * rstd * r0, c = acc[ai][1][m][1] * rstd * r1;
                  u32x4 w; w.x = cvtpk(a[0], a[1]); w.y = cvtpk(a[2], a[3]); w.z = cvtpk(c[0], c[1]); w.w = cvtpk(c[2], c[3]);
                  *(u32x4*)(qrow + 128 + c0n) = w; } }
        asm volatile("s_waitcnt lgkmcnt(0)" ::: "memory"); __builtin_amdgcn_s_barrier(); asm volatile("" ::: "memory");
    }
};
template <class Epi, class Sched, bool ALIGN_EPI = false, bool SP2 = false>
__device__ __forceinline__ void gemm_phase(PG8_LAS unsigned char* lds, const Gemm g, const Sched& S, const Epi& E) {
    int tid_o = threadIdx.x; asm volatile("" : "+v"(tid_o));
    const int tid = tid_o, wid = __builtin_amdgcn_readfirstlane(tid >> 6), lane = tid & 63, wr = wid >> 2, wc = wid & 3, fr = lane & 15, fq = lane >> 4;
    const int K = g.K, nt = K / BK;
    unsigned voffA[2], voffB[2];
#pragma unroll
    for (int i = 0; i < 2; ++i) { int R, C; stage_rc(tid * 16 + i * 8192, R, C); const int Rb = Epi::PERM ? ((R & ~31) + perm32(R & 31)) : R;
        voffA[i] = (unsigned)(R * K + C) * 2u; voffB[i] = (unsigned)(Rb * K + C) * 2u; }
    const size_t kstep = (size_t)(BK * 2);
    const size_t hstep = (size_t)HALF * K * 2;
    const size_t tstep = 2 * hstep;
    const unsigned ldsw = (unsigned)wid * 1024u;
    const int aoff = lds_byte(wr * 64 + fr, fq * 8), boff = lds_byte(wc * 32 + fr, fq * 8);
#define PG8_SA(b, h) (((b) * 2 + (h)) * HTB)
#define PG8_SB(b, h) ((4 + (b) * 2 + (h)) * HTB)
#define PG8_STAGE(bufoff, gbase, voff) do { _Pragma("unroll") for (int _i = 0; _i < 2; ++_i) \
        __builtin_amdgcn_global_load_lds((const unsigned*)((const char*)(gbase) + (voff)[_i]), (PG8_LAS unsigned*)(lds + (bufoff) + ldsw + _i * 8192), 16, 0, 0); } while (0)
#define PG8_LDA(dst, b, h) do { _Pragma("unroll") for (int m = 0; m < 4; ++m) _Pragma("unroll") for (int k = 0; k < 2; ++k) dst[m][k] = *(const PG8_LAS bf16x8*)(lds + PG8_SA(b, h) + aoff + m * 2048 + k * 1024); } while (0)
#define PG8_LDB(dst, b, h) do { _Pragma("unroll") for (int n = 0; n < 2; ++n) _Pragma("unroll") for (int k = 0; k < 2; ++k) dst[n][k] = *(const PG8_LAS bf16x8*)(lds + PG8_SB(b, h) + boff + n * 2048 + k * 1024); } while (0)
#define PG8_MMA(ai, bj, At, Bt) do { __builtin_amdgcn_s_setprio(1); _Pragma("unroll") for (int m = 0; m < 4; ++m) _Pragma("unroll") for (int n = 0; n < 2; ++n) _Pragma("unroll") for (int k = 0; k < 2; ++k) \
        acc[ai][bj][m][n] = __builtin_amdgcn_mfma_f32_16x16x32_bf16(Bt[n][k], At[m][k], acc[ai][bj][m][n], 0, 0, 0); __builtin_amdgcn_s_setprio(0); } while (0)
#define PG8_WAIT_V(n) asm volatile("s_waitcnt vmcnt(" #n ")" ::: "memory")
#define PG8_WAIT_L(n) asm volatile("s_waitcnt lgkmcnt(" #n ")" ::: "memory")
#define PG8_BAR __builtin_amdgcn_s_barrier()
#define PG8_SCHED __builtin_amdgcn_sched_barrier(0)
    Unit cur, nxt; int ui = 0;
    if (!S.next(0, cur)) return;
    f32x4 acc[2][2][4][2];
#pragma unroll
    for (int a = 0; a < 2; ++a)
#pragma unroll
        for (int b = 0; b < 2; ++b)
#pragma unroll
            for (int m = 0; m < 4; ++m)
#pragma unroll
                for (int n = 0; n < 2; ++n) acc[a][b][m][n] = (f32x4){0.f, 0.f, 0.f, 0.f};
    bf16x8 At[4][2], B0[2][2], B1[2][2];
    const char* cA = (const char*)g.A + (size_t)cur.pm * tstep; const char* cB = (const char*)g.Bt + (size_t)cur.pn * tstep;
    S.a_ready(cur);
    if constexpr (SP2) {
        PG8_STAGE(PG8_SB(0, 0), cB, voffB); PG8_STAGE(PG8_SB(0, 1), cB + hstep, voffB); PG8_STAGE(PG8_SA(0, 0), cA, voffA); PG8_STAGE(PG8_SA(0, 1), cA + hstep, voffA);
        if (wr == 1) PG8_BAR;
        PG8_WAIT_V(2); PG8_BAR;
        PG8_STAGE(PG8_SB(1, 0), cB + kstep, voffB); PG8_STAGE(PG8_SA(1, 0), cA + kstep, voffA); PG8_STAGE(PG8_SB(1, 1), cB + hstep + kstep, voffB);
        PG8_WAIT_V(6); PG8_BAR;
    } else {
        PG8_STAGE(PG8_SB(0, 0), cB, voffB); PG8_STAGE(PG8_SA(0, 0), cA, voffA); PG8_STAGE(PG8_SB(0, 1), cB + hstep, voffB); PG8_STAGE(PG8_SA(0, 1), cA + hstep, voffA);
        if (wr == 1) PG8_BAR;
        PG8_WAIT_V(4); PG8_BAR;
        PG8_STAGE(PG8_SB(1, 0), cB + kstep, voffB); PG8_STAGE(PG8_SA(1, 0), cA + kstep, voffA); PG8_STAGE(PG8_SB(1, 1), cB + hstep + kstep, voffB);
        PG8_WAIT_V(6); PG8_BAR;
    }
    for (;;) {
        const bool has_next = S.next(ui + 1, nxt);
        const char* nA = has_next ? (const char*)g.A + (size_t)nxt.pm * tstep : cA; const char* nB = has_next ? (const char*)g.Bt + (size_t)nxt.pn * tstep : cB;
        for (int t = 0; t < nt; t += 2) {
            const bool last = (t == nt - 2);
            const char* a1 = cA + (size_t)(t + 1) * kstep;
            const char* a2 = last ? nA : cA + (size_t)(t + 2) * kstep; const char* b2 = last ? nB : cB + (size_t)(t + 2) * kstep;
            const char* a3 = a2 + kstep; const char* b3 = b2 + kstep;
            if (last && has_next) S.a_ready(nxt);
            if constexpr (SP2) {
            PG8_LDB(B0, 0, 0); PG8_LDB(B1, 0, 1); PG8_SCHED; PG8_LDA(At, 0, 0); PG8_STAGE(PG8_SA(1, 1), a1 + hstep, voffA);
            PG8_WAIT_V(8); PG8_WAIT_L(0); PG8_BAR; PG8_MMA(0, 0, At, B0); PG8_MMA(0, 1, At, B1); PG8_BAR; PG8_SCHED;
            PG8_LDA(At, 0, 1); PG8_STAGE(PG8_SB(0, 0), b2, voffB); PG8_STAGE(PG8_SB(0, 1), b2 + hstep, voffB); PG8_STAGE(PG8_SA(0, 0), a2, voffA);
            PG8_WAIT_V(8); PG8_WAIT_L(0); PG8_BAR; PG8_MMA(1, 0, At, B0); PG8_MMA(1, 1, At, B1); PG8_BAR; PG8_SCHED;
            PG8_LDB(B0, 1, 0); PG8_LDB(B1, 1, 1); PG8_SCHED; PG8_LDA(At, 1, 0); PG8_STAGE(PG8_SA(0, 1), a2 + hstep, voffA);
            PG8_WAIT_V(8); PG8_WAIT_L(0); PG8_BAR; PG8_MMA(0, 0, At, B0); PG8_MMA(0, 1, At, B1); PG8_BAR; PG8_SCHED;
            PG8_LDA(At, 1, 1); PG8_STAGE(PG8_SB(1, 0), b3, voffB); PG8_STAGE(PG8_SB(1, 1), b3 + hstep, voffB); PG8_STAGE(PG8_SA(1, 0), a3, voffA);
            PG8_WAIT_V(8); PG8_WAIT_L(0); PG8_BAR; PG8_MMA(1, 0, At, B0); PG8_MMA(1, 1, At, B1); PG8_BAR; PG8_SCHED;
            } else {
            PG8_LDB(B0, 0, 0); PG8_SCHED; PG8_LDA(At, 0, 0); PG8_STAGE(PG8_SA(1, 1), a1 + hstep, voffA);
            PG8_WAIT_L(8); PG8_BAR; PG8_WAIT_L(0); PG8_MMA(0, 0, At, B0); PG8_BAR; PG8_SCHED;
            PG8_LDB(B1, 0, 1); PG8_STAGE(PG8_SB(0, 0), b2, voffB);
            PG8_BAR; PG8_WAIT_L(0); PG8_MMA(0, 1, At, B1); PG8_BAR;
            PG8_LDA(At, 0, 1); PG8_STAGE(PG8_SA(0, 0), a2, voffA);
            PG8_BAR; PG8_WAIT_L(0); PG8_MMA(1, 0, At, B0); PG8_BAR; PG8_SCHED;
            PG8_STAGE(PG8_SB(0, 1), b2 + hstep, voffB);
            PG8_WAIT_V(6); PG8_BAR; PG8_MMA(1, 1, At, B1); PG8_BAR;
            PG8_LDB(B0, 1, 0); PG8_SCHED; PG8_LDA(At, 1, 0); PG8_STAGE(PG8_SA(0, 1), a2 + hstep, voffA);
            PG8_WAIT_L(8); PG8_BAR; PG8_WAIT_L(0); PG8_MMA(0, 0, At, B0); PG8_BAR; PG8_SCHED;
            PG8_LDB(B1, 1, 1); PG8_STAGE(PG8_SB(1, 0), b3, voffB);
            PG8_BAR; PG8_WAIT_L(0); PG8_MMA(0, 1, At, B1); PG8_BAR;
            PG8_LDA(At, 1, 1); PG8_STAGE(PG8_SA(1, 0), a3, voffA);
            PG8_BAR; PG8_WAIT_L(0); PG8_MMA(1, 0, At, B0); PG8_BAR; PG8_SCHED;
            PG8_STAGE(PG8_SB(1, 1), b3 + hstep, voffB);
            PG8_WAIT_V(6); PG8_BAR; PG8_MMA(1, 1, At, B1); PG8_BAR;
            }
        }
        if constexpr (ALIGN_EPI) { if (wr == 0) PG8_BAR; }
        if constexpr (!Epi::AFTER_DRAIN) { E(acc, cur, wr, wc, fr, fq); S.done(cur); }
        if (!has_next) break;
#pragma unroll
        for (int a = 0; a < 2; ++a)
#pragma unroll
            for (int b = 0; b < 2; ++b)
#pragma unroll
                for (int m = 0; m < 4; ++m)
#pragma unroll
                    for (int n = 0; n < 2; ++n) acc[a][b][m][n] = (f32x4){0.f, 0.f, 0.f, 0.f};
        cur = nxt; cA = nA; cB = nB; ++ui;
        if constexpr (ALIGN_EPI) { if (wr == 1) PG8_BAR; }
    }
    PG8_WAIT_V(0);
    if constexpr (!ALIGN_EPI) { if (wr == 0) PG8_BAR; }
    PG8_BAR;
    if constexpr (Epi::AFTER_DRAIN) { E.fused(acc, cur, wr, wc, fr, fq, lds, wid, lane); S.done(cur); }
#undef PG8_SA
#undef PG8_SB
#undef PG8_STAGE
#undef PG8_LDA
#undef PG8_LDB
#undef PG8_MMA
#undef PG8_WAIT_V
#undef PG8_WAIT_L
#undef PG8_BAR
#undef PG8_SCHED
}
}
#define LAS __attribute__((address_space(3)))
typedef unsigned short bf16;
typedef unsigned v4u __attribute__((ext_vector_type(4)));
typedef unsigned v2u __attribute__((ext_vector_type(2)));
typedef float f32x4 __attribute__((ext_vector_type(4)));
typedef float f32x16 __attribute__((ext_vector_type(16)));
typedef short bf16x8 __attribute__((ext_vector_type(8)));
constexpr int NB = 4, SEQ = 4096, DM = 2048, M = NB * SEQ, DFF = 5632;
constexpr float EPS = 1e-6f;
constexpr size_t MiB = 1u << 20;
constexpr size_t WS_MOD = 1 * MiB, WS_ALR = 2 * MiB, WS_KPE = 3 * MiB, WS_KSS = 7 * MiB;
constexpr size_t WS_W_IN = 8 * MiB, WS_W_GOUT = 32 * MiB, WS_W_GU = 40 * MiB, WS_W_DN = 84 * MiB;
constexpr size_t WS_W_DKV = 8 * MiB  , WS_W_DQ = 8 * MiB, WS_W_UKV = 28 * MiB, WS_W_UQ = 32 * MiB, WS_W_MOUT = 704 * MiB, WS_BP = 7 * MiB + 256 * 1024, WS_PS = 730 * MiB  , WS_RSTD = 732 * MiB  ;
constexpr size_t WS_XR = 106 * MiB  , WS_C = 234 * MiB, WS_B = 298 * MiB, WS_A = 394 * MiB, WS_F = 586 * MiB, WS_END = 746 * MiB;
constexpr size_t WS_CKV = 586 * MiB, WS_CQ = 634 * MiB, WS_CLAT = 666 * MiB, WS_CQN = 682 * MiB, WS_KN = 394 * MiB, WS_VT = 490 * MiB, WS_CS = 700 * MiB;
constexpr int LDS_BYTES = 147456;
constexpr float QSCALE = 0.07216878364870322f * 1.4426950408889634f;
__device__ const double INVF[32] = {1, 0.74989420175552368, 0.56234133243560791, 0.42169651389122009, 0.31622776389122009, 0.23713737726211548, 0.17782793939113617, 0.13335214555263519,
    0.10000000149011612, 0.074989423155784607, 0.056234132498502731, 0.04216964915394783, 0.03162277489900589, 0.023713737726211548, 0.017782794311642647, 0.013335213996469975,
    0.0099999997764825821, 0.0074989423155784607, 0.0056234132498502731, 0.0042169648222625256, 0.0031622776295989752, 0.0023713738191872835, 0.0017782794311642647, 0.0013335214462131262,
    0.0010000000474974513, 0.00074989418499171734, 0.00056234130170196295, 0.0004216965171508491, 0.00031622775713913143, 0.00023713737027719617, 0.00017782794020604342, 0.00013335215044207871};

#define LDS_WAIT() asm volatile("s_waitcnt lgkmcnt(0)" ::: "memory")
__device__ __forceinline__ unsigned pk2(float lo, float hi) { return pg8::cvtpk(lo, hi); }
__device__ __forceinline__ float bflo(unsigned w) { return __uint_as_float(w << 16); }
__device__ __forceinline__ float bfhi(unsigned w) { return __uint_as_float(w & 0xffff0000u); }
__device__ __forceinline__ float bf2f(bf16 u) { return __uint_as_float((unsigned)u << 16); }
__device__ __forceinline__ float dot4(f32x4 a, f32x4 b) { return (a.x * b.x + a.y * b.y) + (a.z * b.z + a.w * b.w); }
__device__ __forceinline__ float wave_sum(float v) {
#pragma unroll
    for (int o = 1; o < 64; o <<= 1) v += __shfl_xor(v, o);
    return v;
}
__device__ __forceinline__ float silu(float g) { return pg8::silu_f(g); }

__device__ __forceinline__ void transpose_item(const float* W, int K, int Nsrc, int scol, bf16* WT, int drow, int k0, LAS float* scr, int lane, int rs = 1, const float* kgain = nullptr, const float* kscale = nullptr) {
    float tv[32];
#pragma unroll
    for (int i = 0; i < 32; ++i) tv[i] = __builtin_nontemporal_load(&W[(size_t)(k0 + 2 * i + (lane >> 5)) * Nsrc + scol + (lane & 31)]);
    if (kgain) {
#pragma unroll
        for (int i = 0; i < 32; ++i) { const int k = k0 + 2 * i + (lane >> 5); tv[i] *= kgain[k] * (1.f + kscale[k]); } }
#pragma unroll
    for (int i = 0; i < 32; ++i) scr[(2 * i + (lane >> 5)) * 33 + (lane & 31)] = tv[i];
    LDS_WAIT(); asm volatile("" ::: "memory");
    const int c = lane & 7;
#pragma unroll
    for (int j = 0; j < 4; ++j) { const int n = (lane >> 3) + 8 * j; const LAS float* s = scr + (8 * c) * 33 + n;
        v4u o; o.x = pk2(s[0 * 33], s[1 * 33]); o.y = pk2(s[2 * 33], s[3 * 33]); o.z = pk2(s[4 * 33], s[5 * 33]); o.w = pk2(s[6 * 33], s[7 * 33]);
        *(v4u*)(WT + (size_t)(drow + n * rs) * K + k0 + 8 * c) = o; }
    LDS_WAIT(); asm volatile("" ::: "memory");
}
__device__ __forceinline__ int gu_row(int c0) { const int s = c0 / DFF, rr = c0 % DFF; return 256 * (rr / 128) + 128 * s + (rr % 128); }

__device__ __forceinline__ void load_row(const float* xrow, int lane, f32x4 (&v)[8]) {
    const f32x4* xr = (const f32x4*)xrow + lane;
#pragma unroll
    for (int j = 0; j < 8; ++j) v[j] = __builtin_nontemporal_load(xr + 64 * j);
}
__device__ __forceinline__ float row_rstd(const f32x4 (&v)[8]) {
    float ss = 0.f;
#pragma unroll
    for (int j = 0; j < 8; ++j) ss += dot4(v[j], v[j]);
    return rsqrtf(wave_sum(ss) * (1.f / 2048.f) + EPS);
}
__device__ __forceinline__ void load_row_rstd(const float* xrow, int lane, f32x4 (&v)[8], float& rstd) {
    const f32x4* xr = (const f32x4*)xrow + lane; float ss = 0.f;
#pragma unroll
    for (int j = 0; j < 8; ++j) { v[j] = xr[64 * j]; ss += dot4(v[j], v[j]); }
    rstd = rsqrtf(wave_sum(ss) * (1.f / 2048.f) + EPS);
}
__device__ __forceinline__ void modulate_store(const f32x4 (&v)[8], float rstd, const float* gain, const float* shift, const float* scale, bf16* orow, int lane, f32x4 (&h)[8]) {
    const f32x4* g4 = (const f32x4*)gain + lane; const f32x4* sh4 = (const f32x4*)shift + lane; const f32x4* sc4 = (const f32x4*)scale + lane;
    unsigned long long* o8 = (unsigned long long*)orow + lane;
#pragma unroll
    for (int j = 0; j < 8; ++j) { h[j] = v[j] * rstd * g4[64 * j] * (1.f + sc4[64 * j]) + sh4[64 * j];
        o8[64 * j] = (unsigned long long)pk2(h[j].x, h[j].y) | ((unsigned long long)pk2(h[j].z, h[j].w) << 32); }
}


#define RLX_AGENT __ATOMIC_RELAXED, __HIP_MEMORY_SCOPE_AGENT
#define XB_TMO      128
#define XB_XCNT(j)  (256  + 64 * (j))
#define XB_XSUB(j)  (1280 + 64 * (j))
#define XB_XGEN(j)  (2304 + 64 * (j))
#define XB_TOP      3328
#define XB_TOPGEN   3392
#define XCD_BAR_WORDS 3456
#define XB_SPIN_CAP (1u << 18)

__device__ __forceinline__ unsigned xb_ld(unsigned* p)              { return __hip_atomic_load(p, __ATOMIC_RELAXED, __HIP_MEMORY_SCOPE_AGENT); }
__device__ __forceinline__ unsigned xb_add(unsigned* p, unsigned v) { return __hip_atomic_fetch_add(p, v, __ATOMIC_RELAXED, __HIP_MEMORY_SCOPE_AGENT); }
__device__ __forceinline__ unsigned xb_xcc_id() { return (unsigned)__builtin_amdgcn_s_getreg((3 << 11) | 20) & 0xFu; }
#define XB_SPIN(cond, bar) do { unsigned _sp = 0; while (cond) { __builtin_amdgcn_s_sleep(1); \
    if ((++_sp & 255u) == 0u) { if (xb_ld(&(bar)[XB_TMO])) break; if (_sp > XB_SPIN_CAP) { atomicAdd(&(bar)[XB_TMO], 1u); break; } } } } while (0)

struct XcdBarrier {
    unsigned* bar; unsigned x;
    volatile LAS unsigned* st;
};

__device__ __forceinline__ XcdBarrier xcd_barrier_post(unsigned* bar, volatile LAS unsigned* st) {
    XcdBarrier b; b.bar = bar; b.x = xb_xcc_id(); b.st = st;
    if (threadIdx.x == 0) (void)xb_add(&bar[XB_XCNT(b.x)], 1u);
    return b;
}
__device__ __forceinline__ void xcd_barrier_complete(unsigned* bar, unsigned x, unsigned& nloc, unsigned& nx) {
    const unsigned G = gridDim.x * gridDim.y * gridDim.z;
    unsigned sum, cnt, mine, sp = 0u;
    for (;;) {
        sum = 0u; cnt = 0u; mine = 0u;
#pragma unroll
        for (unsigned j = 0; j < 16; ++j) { const unsigned c = xb_ld(&bar[XB_XCNT(j)]); sum += c; cnt += (c > 0u) ? 1u : 0u; mine = (j == x) ? c : mine; }
        if (sum == G) break;
        __builtin_amdgcn_s_sleep(1);
        if ((++sp & 255u) == 0u) { if (xb_ld(&bar[XB_TMO])) break; if (sp > XB_SPIN_CAP) { atomicAdd(&bar[XB_TMO], 1u); break; } }
    }
    nloc = mine > 0u ? mine : 1u; nx = cnt > 0u ? cnt : 1u;
}

__device__ __forceinline__ void xcd_barrier(const XcdBarrier& b) {
    asm volatile("s_waitcnt vmcnt(0)" ::: "memory");
    __syncthreads();
    if (threadIdx.x == 0) {
        unsigned* bar = b.bar;
        __builtin_amdgcn_s_waitcnt(0);
        unsigned nloc = b.st[0], nx = b.st[1];
        if (nloc == 0u) { xcd_barrier_complete(bar, b.x, nloc, nx); b.st[0] = nloc; b.st[1] = nx; }
        const unsigned old = xb_add(&bar[XB_XSUB(b.x)], 1u);
        const unsigned gen = old / nloc;
        if (old + 1u == (gen + 1u) * nloc) {
            __builtin_amdgcn_fence(__ATOMIC_RELEASE, "agent");
            asm volatile("s_waitcnt vmcnt(0)" ::: "memory");
            const unsigned og = xb_add(&bar[XB_TOP], 1u);
            const unsigned tg = og / nx;
            if (og + 1u == (tg + 1u) * nx) xb_add(&bar[XB_TOPGEN], 1u);
            else XB_SPIN(xb_ld(&bar[XB_TOPGEN]) == tg, bar);
            __builtin_amdgcn_fence(__ATOMIC_ACQUIRE, "agent");
            xb_add(&bar[XB_XGEN(b.x)], 1u);
            asm volatile("s_waitcnt vmcnt(0)" ::: "memory");
        } else {
            XB_SPIN(xb_ld(&bar[XB_XGEN(b.x)]) == gen, bar);
            __builtin_amdgcn_fence(__ATOMIC_ACQUIRE, "agent");
            asm volatile("s_waitcnt vmcnt(0)" ::: "memory");
        }
    }
    __syncthreads();
}

__device__ __forceinline__ void load_row_bf(const bf16* xrow, int lane, f32x4 (&v)[8]) {
    const v2u* xr = (const v2u*)xrow + lane;
#pragma unroll
    for (int j = 0; j < 8; ++j) { const v2u w = xr[64 * j]; v[j] = (f32x4){bflo(w.x), bfhi(w.x), bflo(w.y), bfhi(w.y)}; }
}
template <typename TS> __device__ __forceinline__ void modulate_pair(const TS* src, int row, int lane, const float* gain1, const float* shift1, const float* scale1, bf16* out1,
                                              const float* gain2, const float* shift2, const float* scale2, bf16* out2) {
    f32x4 va[8], vb[8];
    if constexpr (sizeof(TS) == 4) { load_row((const float*)src + (size_t)row * DM, lane, va); load_row((const float*)src + (size_t)(row + 1) * DM, lane, vb); }
    else { load_row_bf((const bf16*)src + (size_t)row * DM, lane, va); load_row_bf((const bf16*)src + (size_t)(row + 1) * DM, lane, vb); }
    const float ra = row_rstd(va), rb = row_rstd(vb);
    { const f32x4* g4 = (const f32x4*)gain1 + lane; const f32x4* sh4 = (const f32x4*)shift1 + lane; const f32x4* sc4 = (const f32x4*)scale1 + lane;
      unsigned long long* oa = (unsigned long long*)(out1 + (size_t)row * DM) + lane; unsigned long long* ob = oa + DM / 4;
#pragma unroll
      for (int j = 0; j < 8; ++j) { const f32x4 g = g4[64 * j] * (1.f + sc4[64 * j]), sh = sh4[64 * j]; const f32x4 ha = va[j] * ra * g + sh, hb = vb[j] * rb * g + sh;
          oa[64 * j] = (unsigned long long)pk2(ha.x, ha.y) | ((unsigned long long)pk2(ha.z, ha.w) << 32); ob[64 * j] = (unsigned long long)pk2(hb.x, hb.y) | ((unsigned long long)pk2(hb.z, hb.w) << 32); } }
    if (out2) { const f32x4* g4 = (const f32x4*)gain2 + lane; const f32x4* sh4 = (const f32x4*)shift2 + lane; const f32x4* sc4 = (const f32x4*)scale2 + lane;
      unsigned long long* oa = (unsigned long long*)(out2 + (size_t)row * DM) + lane; unsigned long long* ob = oa + DM / 4;
#pragma unroll
      for (int j = 0; j < 8; ++j) { const f32x4 g = g4[64 * j] * (1.f + sc4[64 * j]), sh = sh4[64 * j]; const f32x4 ha = va[j] * ra * g + sh, hb = vb[j] * rb * g + sh;
          oa[64 * j] = (unsigned long long)pk2(ha.x, ha.y) | ((unsigned long long)pk2(ha.z, ha.w) << 32); ob[64 * j] = (unsigned long long)pk2(hb.x, hb.y) | ((unsigned long long)pk2(hb.z, hb.w) << 32); } }
}

#define MFMA32(a, b, c) __builtin_amdgcn_mfma_f32_32x32x16_bf16((a), (b), (c), 0, 0, 0)
constexpr int KT_PITCH = 400, VT_PITCH = 136, KT_BYTES = 64 * KT_PITCH, VT_BYTES = 128 * VT_PITCH, ATT_LDS = KT_BYTES + 2 * VT_BYTES;
__device__ __forceinline__ int crow(int r, int hi) { return (r & 3) + 8 * (r >> 2) + 4 * hi; }
__device__ __forceinline__ void attn_unit(int b, int h, int qb, const bf16* QN, const bf16* KN, const bf16* VT, bf16* AO, LAS unsigned char* lds, int tid) {
    const int lane = tid & 63, r32 = lane & 31, hi = lane >> 5; const int w = __builtin_amdgcn_readfirstlane(tid >> 6);
    const int q0 = qb * 256, NT = (q0 + 256) / 64;
    const bf16* qp = QN + ((size_t)(b * SEQ + q0 + 32 * w + r32)) * 3072 + h * 192 + 8 * hi;
    bf16x8 qf[12];
#pragma unroll
    for (int d0 = 0; d0 < 12; ++d0) qf[d0] = *(const bf16x8*)(qp + 16 * d0);
    f32x16 o[4];
#pragma unroll
    for (int dt = 0; dt < 4; ++dt)
#pragma unroll
        for (int i = 0; i < 16; ++i) o[dt][i] = 0.f;
    float m_run = -INFINITY, l_part = 0.f;
    const bf16* kbase = KN + ((size_t)(b * SEQ)) * 3072 + h * 192; const bf16* vbase = VT + ((size_t)((b * 16 + h) * 128)) * SEQ;
#define KSRC(i) ((((tl + 512 * (i)) / 24) * 3072) + 8 * ((tl + 512 * (i)) % 24))
#define KDST(i) ((((tl + 512 * (i)) / 24) * KT_PITCH) + 16 * ((tl + 512 * (i)) % 24))
#define VSRC(i) ((((tl + 512 * (i)) >> 3) * SEQ) + 8 * ((tl + 512 * (i)) & 7))
#define VDST(i) (KT_BYTES + (((tl + 512 * (i)) >> 3) * VT_PITCH) + 16 * ((tl + 512 * (i)) & 7))
    v4u kreg[3], vreg[2];
    int tl = tid; asm volatile("" : "+v"(tl));
#pragma unroll
    for (int i = 0; i < 3; ++i) kreg[i] = *(const v4u*)(kbase + KSRC(i));
#pragma unroll
    for (int i = 0; i < 2; ++i) vreg[i] = *(const v4u*)(vbase + VSRC(i));
#define PV_BLOCK(VB_) do { \
        const LAS unsigned char* vb0 = lds + KT_BYTES + (VB_) * VT_BYTES + r32 * VT_PITCH + (4 * hi) * 2; \
        v2u vl[2][4], vh[2][4]; \
        _Pragma("unroll") for (int dt = 0; dt < 4; ++dt) { vl[0][dt] = *(const LAS v2u*)(vb0 + dt * 32 * VT_PITCH); vh[0][dt] = *(const LAS v2u*)(vb0 + dt * 32 * VT_PITCH + 16); } \
        _Pragma("unroll") for (int cmb = 0; cmb < 4; ++cmb) { \
            const int u = cmb >> 1, s = cmb & 1; \
            if (cmb + 1 < 4) { const LAS unsigned char* vb = vb0 + (32 * ((cmb + 1) >> 1) + 16 * ((cmb + 1) & 1)) * 2; \
                _Pragma("unroll") for (int dt = 0; dt < 4; ++dt) { vl[(cmb + 1) & 1][dt] = *(const LAS v2u*)(vb + dt * 32 * VT_PITCH); vh[(cmb + 1) & 1][dt] = *(const LAS v2u*)(vb + dt * 32 * VT_PITCH + 16); } } \
            v4u pw; \
            if (u == 0) { pw.x = pk2(p0[8 * s], p0[8 * s + 1]); pw.y = pk2(p0[8 * s + 2], p0[8 * s + 3]); pw.z = pk2(p0[8 * s + 4], p0[8 * s + 5]); pw.w = pk2(p0[8 * s + 6], p0[8 * s + 7]); } \
            else        { pw.x = pk2(p1[8 * s], p1[8 * s + 1]); pw.y = pk2(p1[8 * s + 2], p1[8 * s + 3]); pw.z = pk2(p1[8 * s + 4], p1[8 * s + 5]); pw.w = pk2(p1[8 * s + 6], p1[8 * s + 7]); } \
            const bf16x8 pb = __builtin_bit_cast(bf16x8, pw); \
            __builtin_amdgcn_sched_barrier(0); \
            _Pragma("unroll") for (int dt = 0; dt < 4; ++dt) { const v4u av = (v4u){vl[cmb & 1][dt].x, vl[cmb & 1][dt].y, vh[cmb & 1][dt].x, vh[cmb & 1][dt].y}; \
                o[dt] = MFMA32(__builtin_bit_cast(bf16x8, av), pb, o[dt]); } \
            __builtin_amdgcn_sched_barrier(0); \
        } } while (0)
    f32x16 p0, p1; bool pend = false;
    for (int t = 0; t < NT; ++t) {
        __syncthreads();
        tl = tid; asm volatile("" : "+v"(tl));
#pragma unroll
        for (int i = 0; i < 3; ++i) *(LAS v4u*)(lds + KDST(i)) = kreg[i];
#pragma unroll
        for (int i = 0; i < 2; ++i) { LAS v2u* d = (LAS v2u*)(lds + (t & 1) * VT_BYTES + VDST(i)); d[0] = (v2u){vreg[i].x, vreg[i].y}; d[1] = (v2u){vreg[i].z, vreg[i].w}; }
        __syncthreads();
        if (t + 1 < NT) {
#pragma unroll
            for (int i = 0; i < 3; ++i) kreg[i] = *(const v4u*)(kbase + (size_t)(t + 1) * 64 * 3072 + KSRC(i));
#pragma unroll
            for (int i = 0; i < 2; ++i) vreg[i] = *(const v4u*)(vbase + (t + 1) * 64 + VSRC(i));
        }
        if (w >= 4 && pend) { PV_BLOCK((t - 1) & 1); pend = false; }
        const int jb = t - (NT - 4);
        if (jb >= 0 && 64 * jb > 32 * w + 31) continue;
#pragma unroll
        for (int i = 0; i < 16; ++i) { p0[i] = 0.f; p1[i] = 0.f; }
        const LAS unsigned char* kb = lds + r32 * KT_PITCH + hi * 16;
        bf16x8 ka[2][2];
        ka[0][0] = *(const LAS bf16x8*)(kb); ka[0][1] = *(const LAS bf16x8*)(kb + 32 * KT_PITCH);
#pragma unroll
        for (int d0 = 0; d0 < 12; ++d0) {
            if (d0 + 1 < 12) { ka[(d0 + 1) & 1][0] = *(const LAS bf16x8*)(kb + (d0 + 1) * 32); ka[(d0 + 1) & 1][1] = *(const LAS bf16x8*)(kb + 32 * KT_PITCH + (d0 + 1) * 32); }
            __builtin_amdgcn_sched_barrier(0);
            p0 = MFMA32(ka[d0 & 1][0], qf[d0], p0); p1 = MFMA32(ka[d0 & 1][1], qf[d0], p1);
            __builtin_amdgcn_sched_barrier(0);
        }
        if (jb >= 0) { const int qrel = 32 * w + r32;
#pragma unroll
            for (int i = 0; i < 16; ++i) { const int kv = 64 * jb + crow(i, hi); if (kv > qrel) p0[i] = -INFINITY; if (kv + 32 > qrel) p1[i] = -INFINITY; } }
        float mx = fmaxf(p0[0], p1[0]);
#pragma unroll
        for (int i = 1; i < 16; ++i) mx = fmaxf(mx, fmaxf(p0[i], p1[i]));
        { const auto rr = __builtin_amdgcn_permlane32_swap(__float_as_uint(mx), __float_as_uint(mx), false, false); mx = fmaxf(__uint_as_float(rr[0]), __uint_as_float(rr[1])); }
        const float m_new = fmaxf(m_run, mx), alpha = __builtin_amdgcn_exp2f(m_run - m_new); m_run = m_new;
        float rs = 0.f;
#pragma unroll
        for (int i = 0; i < 16; ++i) { p0[i] = __builtin_amdgcn_exp2f(p0[i] - m_new); p1[i] = __builtin_amdgcn_exp2f(p1[i] - m_new); rs += p0[i] + p1[i]; }
        l_part = l_part * alpha + rs;
        if (__builtin_amdgcn_ballot_w64(alpha != 1.0f) != 0ull) {
#pragma unroll
            for (int dt = 0; dt < 4; ++dt)
#pragma unroll
                for (int i = 0; i < 16; ++i) o[dt][i] *= alpha;
        }
        if (w < 4) PV_BLOCK(t & 1); else pend = true;
    }
    if (pend) PV_BLOCK((NT - 1) & 1);
#undef PV_BLOCK
    const float l = l_part + __shfl_xor(l_part, 32), inv = 1.f / l;
    bf16* op = AO + ((size_t)(b * SEQ + q0 + 32 * w + r32)) * 2048 + h * 128 + 4 * hi;
#pragma unroll
    for (int dt = 0; dt < 4; ++dt)
#pragma unroll
        for (int g = 0; g < 4; ++g) { v2u ov; ov.x = pk2(o[dt][4 * g] * inv, o[dt][4 * g + 1] * inv); ov.y = pk2(o[dt][4 * g + 2] * inv, o[dt][4 * g + 3] * inv);
            *(v2u*)(op + 32 * dt + 8 * g) = ov; }
}

struct Args { const void* in[26]; float* out; unsigned char* ws; };
typedef const __attribute__((address_space(4))) Args* ArgsP;
__global__ void __launch_bounds__(512, 2) fwd(Args a) {
    extern __shared__ __attribute__((aligned(16))) unsigned char lds_raw[];
    LAS unsigned char* lds = (LAS unsigned char*)lds_raw;
    cg::grid_group grid = cg::this_grid();
    const int G = gridDim.x, NGW = G * 8, NT = G * 512;
    const int vcu = (G % 8 == 0) ? (int)(blockIdx.x % 8) * (G / 8) + (int)(blockIdx.x / 8) : (int)blockIdx.x;
#define ROW0(pairs) ((G == 256) ? vcu * 64 + wave * 8 : ((pairs) ? 2 * gw : gw))
#define ROWSTEP(pairs) ((G == 256) ? ((pairs) ? 2 : 1) : ((pairs) ? 2 * NGW : NGW))
#define ROWEND(r0) ((G == 256) ? (r0) + 8 : M)
#define PV() ArgsP ap_ = (ArgsP)__builtin_amdgcn_kernarg_segment_ptr(); asm volatile("" : "+s"(ap_)); unsigned char* ws = ap_->ws; (void)ws; int tid_ = threadIdx.x; asm volatile("" : "+v"(tid_)); const int tid = tid_, lane = tid & 63, wave = __builtin_amdgcn_readfirstlane(tid >> 6), gw = blockIdx.x * 8 + wave, gt = blockIdx.x * 512 + tid; (void)lane; (void)gw; (void)gt; (void)wave
    unsigned* xbar_words = (unsigned*)a.ws;
    volatile LAS unsigned* xst = (volatile LAS unsigned*)(lds + LDS_BYTES - 64);
    if (threadIdx.x < 2) xst[threadIdx.x] = 0u;
    if (blockIdx.x == 0) for (int i = threadIdx.x; i < XCD_BAR_WORDS; i += 512) xbar_words[i] = 0u;
    __syncthreads();


    { PV(); const float* cvec = (const float*)ap_->in[1]; const float* ada_w = (const float*)ap_->in[3]; const float* ada_b = (const float*)ap_->in[4]; const float* kv_ada_w = (const float*)ap_->in[17]; const float* kv_ada_b = (const float*)ap_->in[18]; float* mod = (float*)(ws + WS_MOD); float* mod0 = mod; float* mod1 = mod + 49152; float* modkv = mod + 98304;
    {
        LAS float* sc = (LAS float*)lds; LAS float* red = (LAS float*)(lds + 32768);
        if (blockIdx.x < 224) for (int i = tid; i < 8192; i += 512) { const float v = cvec[i]; sc[i] = v / (1.f + __expf(-v)); }
        __syncthreads();
        for (int item = blockIdx.x; item < 224; item += G) {
            const int J0 = item * 128; const float* W; const float* bias; float* dst; int N;
            if (J0 < 12288) { W = ada_w + J0; bias = ada_b + J0; dst = mod0 + J0; N = 12288; }
            else if (J0 < 24576) { const int cc = J0 - 12288; W = ada_w + (size_t)2048 * 12288 + cc; bias = ada_b + 12288 + cc; dst = mod1 + cc; N = 12288; }
            else { const int cc = J0 - 24576; W = kv_ada_w + cc; bias = kv_ada_b + cc; dst = modkv + cc; N = 4096; }
            const int hw = tid >> 5, ln = tid & 31;
            const float* wp = W + (size_t)(hw * 128) * N + 4 * ln;
            f32x4 acc0 = {0.f, 0.f, 0.f, 0.f}, acc1 = acc0, acc2 = acc0, acc3 = acc0;
#pragma unroll 8
            for (int k = 0; k < 128; ++k) { const f32x4 wv = __builtin_nontemporal_load((const f32x4*)(wp + (size_t)k * N)); const int kk = hw * 128 + k;
                acc0 += sc[kk] * wv; acc1 += sc[2048 + kk] * wv; acc2 += sc[4096 + kk] * wv; acc3 += sc[6144 + kk] * wv; }
            *(LAS f32x4*)(red + (hw * 4 + 0) * 128 + 4 * ln) = acc0; *(LAS f32x4*)(red + (hw * 4 + 1) * 128 + 4 * ln) = acc1;
            *(LAS f32x4*)(red + (hw * 4 + 2) * 128 + 4 * ln) = acc2; *(LAS f32x4*)(red + (hw * 4 + 3) * 128 + 4 * ln) = acc3;
            __syncthreads();
            { const int b = tid >> 7, cc = tid & 127; float s = 0.f;
#pragma unroll
              for (int h2 = 0; h2 < 16; ++h2) s += red[(h2 * 4 + b) * 128 + cc];
              dst[(size_t)b * N + cc] = s + bias[cc]; }
            __syncthreads();
        }
    }
    }
    { PV(); const float* x = (const float*)ap_->in[0]; const float* gla_w_in = (const float*)ap_->in[7]; const float* gla_w_out = (const float*)ap_->in[11]; const float* ffn_w_gu = (const float*)ap_->in[24]; const float* ffn_w_down = (const float*)ap_->in[25]; float* ALR = (float*)(ws + WS_ALR); bf16* W_IN_T = (bf16*)(ws + WS_W_IN); bf16* W_GOUT_T = (bf16*)(ws + WS_W_GOUT); bf16* W_GU_T = (bf16*)(ws + WS_W_GU); bf16* W_DN_T = (bf16*)(ws + WS_W_DN); bf16* H = (bf16*)(ws + WS_C);
    {
        LAS float* scr = (LAS float*)(lds + wave * 16384);
        constexpr int I_IN = 32 * 192, I_GOUT = 32 * 64, I_GU = 32 * 352, I_DN = 88 * 64;
        for (int it = gw; it < I_IN + I_GOUT + I_GU + I_DN; it += NGW) {
            int r = it;
            if (r < I_IN) { const int kb = r / 192, nb = r % 192; transpose_item(gla_w_in, 2048, 6160, 32 * nb, W_IN_T, 32 * nb, 64 * kb, scr, lane); continue; } r -= I_IN;
            if (r < I_GOUT) { const int kb = r / 64, nb = r % 64; transpose_item(gla_w_out, 2048, 2048, 32 * nb, W_GOUT_T, 32 * nb, 64 * kb, scr, lane); continue; } r -= I_GOUT;
            if (r < I_GU) { const int kb = r / 352, nb = r % 352; transpose_item(ffn_w_gu, 2048, 2 * DFF, 32 * nb, W_GU_T, gu_row(32 * nb), 64 * kb, scr, lane); continue; } r -= I_GU;
            { const int kb = r / 64, nb = r % 64; transpose_item(ffn_w_down, DFF, 2048, 32 * nb, W_DN_T, 32 * nb, 64 * kb, scr, lane); }
        }
    }
    }
    grid.sync();
    XcdBarrier xb = xcd_barrier_post(xbar_words, xst);
    { PV(); const float* x = (const float*)ap_->in[0]; const float* norm_mix = (const float*)ap_->in[5]; const float* gla_w_in = (const float*)ap_->in[7]; float* mod = (float*)(ws + WS_MOD); float* mod0 = mod; float* ALR = (float*)(ws + WS_ALR); bf16* H = (bf16*)(ws + WS_C); bf16* PROJ = (bf16*)(ws + WS_A);
    {
        LAS float* wat = (LAS float*)lds;
        for (int i = tid; i < 32768; i += 512) { const int k = i >> 4, o = i & 15; wat[o * 2048 + k] = gla_w_in[(size_t)k * 6160 + 6144 + o]; }
        __syncthreads();
        const int r0_ = ROW0(0), rstep_ = ROWSTEP(0), rend_ = ROWEND(r0_);
        f32x4 vn[8]; load_row(x + (size_t)r0_ * DM, lane, vn);
        for (int row = r0_; row < rend_; row += rstep_) {
            const int b = row >> 12; f32x4 v[8], h[8];
#pragma unroll
            for (int j = 0; j < 8; ++j) v[j] = vn[j];
            if (row + rstep_ < rend_) load_row(x + (size_t)(row + rstep_) * DM, lane, vn);
            const float rstd = row_rstd(v);
            modulate_store(v, rstd, norm_mix, mod0 + (size_t)b * 12288, mod0 + (size_t)b * 12288 + 2048, H + (size_t)row * DM, lane, h);
#pragma unroll 1
            for (int og = 0; og < 2; ++og) {
                float a8[8];
#pragma unroll
                for (int oo = 0; oo < 8; ++oo) { float acc = 0.f;
#pragma unroll
                    for (int j = 0; j < 8; ++j) acc += dot4(h[j], *(const LAS f32x4*)(wat + (og * 8 + oo) * 2048 + 256 * j + 4 * lane));
                    a8[oo] = acc; if (oo & 1) __builtin_amdgcn_sched_barrier(0); }
                const bool b5 = (lane & 32) != 0, b4 = (lane & 16) != 0, b3 = (lane & 8) != 0;
                float a4[4], a2[2];
#pragma unroll
                for (int i = 0; i < 4; ++i) { const float keep = b5 ? a8[i + 4] : a8[i], send = b5 ? a8[i] : a8[i + 4]; a4[i] = keep + __shfl_xor(send, 32); }
#pragma unroll
                for (int i = 0; i < 2; ++i) { const float keep = b4 ? a4[i + 2] : a4[i], send = b4 ? a4[i] : a4[i + 2]; a2[i] = keep + __shfl_xor(send, 16); }
                float a1; { const float keep = b3 ? a2[1] : a2[0], send = b3 ? a2[0] : a2[1]; a1 = keep + __shfl_xor(send, 8); }
                a1 += __shfl_xor(a1, 4); a1 += __shfl_xor(a1, 2); a1 += __shfl_xor(a1, 1);
                if ((lane & 7) == 0) ALR[(size_t)row * 16 + og * 8 + 4 * ((lane >> 5) & 1) + 2 * ((lane >> 4) & 1) + ((lane >> 3) & 1)] = a1;
            }
        }
    }
    }
    xcd_barrier(xb);
#ifndef REP_P2
#define REP_P2 1
#endif
    for (int rep_ = 0; rep_ < REP_P2; ++rep_) {
    { PV(); bf16* W_IN_T = (bf16*)(ws + WS_W_IN); bf16* H = (bf16*)(ws + WS_C); bf16* PROJ = (bf16*)(ws + WS_A);
    { pg8::Gemm g{H, W_IN_T, M, 6144, 2048}; pg8::StaticOrder S; S.init(M, 6144, G, (int)blockIdx.x); pg8::EpiStoreBf16 E{PROJ, 6144};
      pg8::gemm_phase<pg8::EpiStoreBf16, pg8::StaticOrder, true, true>(lds, g, S, E); }
    }
    xcd_barrier(xb);
    }
#ifndef REP_GLA
#define REP_GLA 1
#endif
    for (int rep_ = 0; rep_ < REP_GLA; ++rep_) {
#ifndef REP_PREP
#define REP_PREP 1
#endif
    for (int rp_ = 0; rp_ < REP_PREP; ++rp_) {
    { PV(); const float* gla_w_alpha = (const float*)ap_->in[8]; const float* gla_b_alpha = (const float*)ap_->in[9]; float* ALR = (float*)(ws + WS_ALR); bf16* PROJ = (bf16*)(ws + WS_A);
        LAS float* alr_s = (LAS float*)lds; LAS float* tot_s = (LAS float*)(lds + 4096);
        LAS unsigned char* qd_s = lds + 8192; LAS unsigned char* ki_s = lds + 8192 + 33792; LAS unsigned char* v_s = lds + 8192 + 2 * 33792;
        const int dk = tid & 255, half = tid >> 8, l16 = lane & 15, quad = lane >> 4;
        for (int unit = blockIdx.x; unit < 1024; unit += G) {
            const int bh = unit >> 6, c = unit & 63, b = bh >> 2, h = bh & 3;
            const size_t row0 = (size_t)b * SEQ + c * 64; const size_t uc = (size_t)bh * 64 + c;
            { v4u qr[4], kr[4], vr[8];
              const bf16* qsrc = PROJ + (row0 + (tid >> 5)) * 6144 + h * 256 + 8 * (tid & 31);
#pragma unroll
              for (int i = 0; i < 4; ++i) { qr[i] = *(const v4u*)(qsrc + (size_t)i * 16 * 6144); kr[i] = *(const v4u*)(qsrc + (size_t)i * 16 * 6144 + 1024); }
              const bf16* vsrc = PROJ + (row0 + (tid >> 6)) * 6144 + 2048 + h * 512 + 8 * (tid & 63);
#pragma unroll
              for (int i = 0; i < 8; ++i) vr[i] = *(const v4u*)(vsrc + (size_t)i * 8 * 6144);
              if (tid < 256) *(LAS f32x4*)(alr_s + 4 * tid) = *(const f32x4*)(ALR + row0 * 16 + 4 * tid);
#pragma unroll
              for (int i = 0; i < 4; ++i) { *(LAS v4u*)(qd_s + ((tid >> 5) + 16 * i) * 528 + 16 * (tid & 31)) = qr[i]; *(LAS v4u*)(ki_s + ((tid >> 5) + 16 * i) * 528 + 16 * (tid & 31)) = kr[i]; }
#pragma unroll
              for (int i = 0; i < 8; ++i) *(LAS v4u*)(v_s + ((tid >> 6) + 8 * i) * 1040 + 16 * (tid & 63)) = vr[i]; }
            float wa[16];
#pragma unroll
            for (int r = 0; r < 16; ++r) wa[r] = gla_w_alpha[r * 1024 + h * 256 + dk];
            const float ba = gla_b_alpha[h * 256 + dk];
            __syncthreads();
            float bc[32]; float run = 0.f;
#pragma unroll
            for (int t = 0; t < 32; ++t) { const LAS f32x4* ar = (const LAS f32x4*)(alr_s + (half * 32 + t) * 16); float z = ba;
#pragma unroll
                for (int r4 = 0; r4 < 4; ++r4) { const f32x4 av = ar[r4]; z += av.x * wa[4 * r4] + av.y * wa[4 * r4 + 1] + av.z * wa[4 * r4 + 2] + av.w * wa[4 * r4 + 3]; }
                const float ls = fminf(z, 0.f) - __logf(1.f + __expf(-fabsf(z))); run += ls * 0.0625f; bc[t] = run; }
            tot_s[half * 256 + dk] = run;
            __syncthreads();
            const float bl = tot_s[dk] + tot_s[256 + dk], off = half ? tot_s[dk] : 0.f, ebl = __expf(bl);
            unsigned ksp[16];
#pragma unroll
            for (int t = 0; t < 32; ++t) { const float bct = bc[t] + off; LAS bf16* qe = (LAS bf16*)(qd_s + (half * 32 + t) * 528 + dk * 2); LAS bf16* ke = (LAS bf16*)(ki_s + (half * 32 + t) * 528 + dk * 2);
                const float q = bf2f(*qe), k = bf2f(*ke); const float e = __expf(bct), ki = k * __builtin_amdgcn_rcpf(e);
                const unsigned qd16 = pk2(q * 0.0625f * e, 0.f) & 0xffffu, ki16 = pk2(ki, 0.f) & 0xffffu, ks16 = pk2(ki * ebl, 0.f) & 0xffffu;
                *qe = (bf16)qd16; *ke = (bf16)ki16;
                if (t & 1) ksp[t >> 1] |= ks16 << 16; else ksp[t >> 1] = ks16; }
            { v4u* kd = (v4u*)((bf16*)(ws + WS_F + 32 * MiB) + (uc * 256 + dk) * 64 + half * 32);
#pragma unroll
              for (int i = 0; i < 4; ++i) kd[i] = (v4u){ksp[4 * i], ksp[4 * i + 1], ksp[4 * i + 2], ksp[4 * i + 3]}; }
            if (half == 0) ((float*)(ws + WS_F + 136 * MiB))[uc * 256 + dk] = ebl;
            __syncthreads();
            { const int ti = wave >> 1; bf16* attg = (bf16*)(ws + WS_F + 128 * MiB) + (uc * 64 + 16 * ti + l16) * 64 + 4 * quad;
#pragma unroll
              for (int tt = 0; tt < 2; ++tt) { const int tj = 2 * (wave & 1) + tt; f32x4 acc = {0.f, 0.f, 0.f, 0.f};
                  if (tj <= ti) {
#pragma unroll
                      for (int ks = 0; ks < 8; ++ks) { const bf16x8 ka = *(const LAS bf16x8*)(ki_s + (16 * tj + l16) * 528 + (32 * ks + 8 * quad) * 2), qb = *(const LAS bf16x8*)(qd_s + (16 * ti + l16) * 528 + (32 * ks + 8 * quad) * 2);
                          acc = __builtin_amdgcn_mfma_f32_16x16x32_bf16(ka, qb, acc, 0, 0, 0); }
                      const int ii = 16 * ti + l16, jj = 16 * tj + 4 * quad;
#pragma unroll
                      for (int e = 0; e < 4; ++e) if (jj + e > ii) acc[e] = 0.f; }
                  *(v2u*)(attg + 16 * tj) = (v2u){pk2(acc[0], acc[1]), pk2(acc[2], acc[3])}; } }
            { bf16* qdg = (bf16*)(ws + WS_F) + (uc * 64 + (tid >> 5)) * 256 + 8 * (tid & 31);
#pragma unroll
              for (int i = 0; i < 4; ++i) *(v4u*)(qdg + (size_t)i * 16 * 256) = *(const LAS v4u*)(qd_s + ((tid >> 5) + 16 * i) * 528 + 16 * (tid & 31)); }
            { unsigned vp[32];
#pragma unroll
              for (int t = 0; t < 64; ++t) { const unsigned val = *(const LAS bf16*)(v_s + t * 1040 + tid * 2); if (t & 1) vp[t >> 1] |= val << 16; else vp[t >> 1] = val; }
              v4u* vd = (v4u*)((bf16*)(ws + WS_F + 64 * MiB) + (uc * 512 + tid) * 64);
#pragma unroll
              for (int i = 0; i < 8; ++i) vd[i] = (v4u){vp[4 * i], vp[4 * i + 1], vp[4 * i + 2], vp[4 * i + 3]}; }
            __syncthreads();
        }
    }
    xcd_barrier(xb);
    }
    { PV(); bf16* H = (bf16*)(ws + WS_C); bf16* OG = H; bf16* GLAO = (bf16*)(ws + WS_B);
        const bf16* QD = (const bf16*)(ws + WS_F); const bf16* KST = (const bf16*)(ws + WS_F + 32 * MiB); const bf16* VTG = (const bf16*)(ws + WS_F + 64 * MiB);
        const bf16* ATT = (const bf16*)(ws + WS_F + 128 * MiB); const float* DEC = (const float*)(ws + WS_F + 136 * MiB);
        constexpr int SB_BYTES = 16896, QD_P = 528, AT_P = 144, STG_BYTES = 64 * QD_P + 64 * AT_P + 32 * AT_P, STG0 = 2 * SB_BYTES, O_ATT = 64 * QD_P, O_V = O_ATT + 64 * AT_P;
        const int l32 = lane & 31, hi = lane >> 5, l16 = lane & 15, quad = lane >> 4, ti = wave >> 1, tj = wave & 1;
        for (int item = vcu; item < 256; item += G) {
            const int bh = item >> 4, sl = item & 15, b = bh >> 2, h = bh & 3;
            f32x16 S;
#pragma unroll
            for (int i = 0; i < 16; ++i) S[i] = 0.f;
            const bf16* kst_w = KST + ((size_t)bh * 64 * 256 + 32 * wave + l32) * 64 + 8 * hi;
            const float* dec_w = DEC + (size_t)bh * 64 * 256 + 32 * wave + 4 * hi;
            bf16* o_out = GLAO + ((size_t)b * SEQ + 16 * ti + l16) * DM + h * 512 + 32 * sl + 16 * tj + 4 * quad;
            const bf16* qd_g = QD + (size_t)bh * 64 * 64 * 256 + (size_t)(tid >> 5) * 256 + 8 * (tid & 31);
            const bf16* at_g = ATT + (size_t)bh * 64 * 64 * 64 + (size_t)(tid >> 3) * 64 + 8 * (tid & 7);
            const bf16* vt_g = VTG + ((size_t)bh * 64 * 512 + 32 * sl + ((tid >> 3) & 31)) * 64 + 8 * (tid & 7);
            const int qd_l = (tid >> 5) * QD_P + 16 * (tid & 31), at_l = O_ATT + (tid >> 3) * AT_P + 16 * (tid & 7), vt_l = O_V + ((tid >> 3) & 31) * AT_P + 16 * (tid & 7);
            v4u sq[4], sa, sv; bf16x8 ka[4], kn[4]; f32x4 dc[4], dn[4];
#define GL_STAGE(c_) do { _Pragma("unroll") for (int i = 0; i < 4; ++i) sq[i] = *(const v4u*)(qd_g + (size_t)(c_) * 64 * 256 + i * 16 * 256); sa = *(const v4u*)(at_g + (size_t)(c_) * 4096); if (tid < 256) sv = *(const v4u*)(vt_g + (size_t)(c_) * 512 * 64); } while (0)
#define ST_STAGE(c_) do { LAS unsigned char* sg = lds + STG0 + ((c_) & 1) * STG_BYTES; _Pragma("unroll") for (int i = 0; i < 4; ++i) *(LAS v4u*)(sg + qd_l + i * 16 * QD_P) = sq[i]; *(LAS v4u*)(sg + at_l) = sa; if (tid < 256) *(LAS v4u*)(sg + vt_l) = sv; } while (0)
#define GL_KD(c_, K_, D_) do { _Pragma("unroll") for (int s2 = 0; s2 < 4; ++s2) { K_[s2] = *(const bf16x8*)(kst_w + (size_t)(c_) * 256 * 64 + 16 * s2); D_[s2] = *(const f32x4*)(dec_w + (c_) * 256 + 8 * s2); } } while (0)
            GL_STAGE(0); GL_KD(0, ka, dc);
            ST_STAGE(0);
            GL_STAGE(1);
#pragma unroll 1
            for (int c = 0; c < 64; ++c) {
                const int cn = (c + 1 < 64) ? c + 1 : c;
                GL_KD(cn, kn, dn);
                LAS unsigned char* sb = lds + (c & 1) * SB_BYTES; const LAS unsigned char* sg = lds + STG0 + (c & 1) * STG_BYTES;
#pragma unroll
                for (int g2 = 0; g2 < 4; ++g2) *(LAS v2u*)(sb + l32 * 528 + (32 * wave + 8 * g2 + 4 * hi) * 2) = (v2u){pk2(S[4 * g2], S[4 * g2 + 1]), pk2(S[4 * g2 + 2], S[4 * g2 + 3])};
                __syncthreads();
#pragma unroll
                for (int g2 = 0; g2 < 4; ++g2) { S[4 * g2] *= dc[g2].x; S[4 * g2 + 1] *= dc[g2].y; S[4 * g2 + 2] *= dc[g2].z; S[4 * g2 + 3] *= dc[g2].w; }
#pragma unroll
                for (int s2 = 0; s2 < 4; ++s2) { const bf16x8 vb = *(const LAS bf16x8*)(sg + O_V + l32 * AT_P + (16 * s2 + 8 * hi) * 2); S = MFMA32(ka[s2], vb, S); }
                f32x4 oa = {0.f, 0.f, 0.f, 0.f};
#pragma unroll
                for (int ks = 0; ks < 2; ++ks) { const bf16x8 va = *(const LAS bf16x8*)(sg + O_V + (16 * tj + l16) * AT_P + (32 * ks + 8 * quad) * 2), ab = *(const LAS bf16x8*)(sg + O_ATT + (16 * ti + l16) * AT_P + (32 * ks + 8 * quad) * 2);
                    oa = __builtin_amdgcn_mfma_f32_16x16x32_bf16(va, ab, oa, 0, 0, 0); }
#pragma unroll
                for (int ks = 0; ks < 8; ++ks) { const bf16x8 sa2 = *(const LAS bf16x8*)(sb + (16 * tj + l16) * 528 + (32 * ks + 8 * quad) * 2), qb = *(const LAS bf16x8*)(sg + (16 * ti + l16) * QD_P + (32 * ks + 8 * quad) * 2);
                    oa = __builtin_amdgcn_mfma_f32_16x16x32_bf16(sa2, qb, oa, 0, 0, 0); }
                *(v2u*)(o_out + (size_t)c * 64 * DM) = (v2u){pk2(oa[0], oa[1]), pk2(oa[2], oa[3])};
                if (c + 1 < 64) { ST_STAGE(c + 1); if (c + 2 < 64) GL_STAGE(c + 2); }
#pragma unroll
                for (int s2 = 0; s2 < 4; ++s2) { ka[s2] = kn[s2]; dc[s2] = dn[s2]; }
            }
            __syncthreads();
#undef GL_STAGE
#undef ST_STAGE
#undef GL_KD
        }
    }
    xcd_barrier(xb);
    }
#ifdef EXTRA_SYNCS
    for (int es_ = 0; es_ < EXTRA_SYNCS; ++es_) xcd_barrier(xb);
#endif
    { PV(); const float* x = (const float*)ap_->in[0]; const float* gla_onorm = (const float*)ap_->in[10]; float* XR = (float*)(ws + WS_XR); bf16* H = (bf16*)(ws + WS_C); bf16* OG = H; bf16* GLAO = (bf16*)(ws + WS_B); bf16* PROJ = (bf16*)(ws + WS_A);
    for (int row = ROW0(0), rend_ = ROWEND(row), rstep_ = ROWSTEP(0); row < rend_; row += rstep_) {
        const int hh = lane >> 4, l16 = lane & 15;
        const v4u* op = (const v4u*)(GLAO + (size_t)row * DM + hh * 512 + l16 * 32); const v4u* gp = (const v4u*)(PROJ + (size_t)row * 6144 + 4096 + hh * 512 + l16 * 32);
        v4u ov[4], gv[4]; float ss = 0.f;
#pragma unroll
        for (int i = 0; i < 4; ++i) { ov[i] = op[i]; gv[i] = gp[i]; }
#pragma unroll
        for (int i = 0; i < 4; ++i)
#pragma unroll
            for (int e = 0; e < 4; ++e) { const float lo = bflo(ov[i][e]), hi = bfhi(ov[i][e]); ss += lo * lo + hi * hi; }
        ss += __shfl_xor(ss, 1); ss += __shfl_xor(ss, 2); ss += __shfl_xor(ss, 4); ss += __shfl_xor(ss, 8);
        const float rstd = rsqrtf(ss * (1.f / 512.f) + EPS);
        const float* on = gla_onorm + l16 * 32; v4u* dst = (v4u*)(OG + (size_t)row * DM + hh * 512 + l16 * 32);
#pragma unroll
        for (int i = 0; i < 4; ++i) { v4u w;
#pragma unroll
            for (int e = 0; e < 4; ++e) { const int idx = i * 8 + e * 2;
                const float lo = bflo(ov[i][e]) * rstd * on[idx] * silu(bflo(gv[i][e])), hi = bfhi(ov[i][e]) * rstd * on[idx + 1] * silu(bfhi(gv[i][e]));
                w[e] = pk2(lo, hi); }
            dst[i] = w; }
    }
    }
    xcd_barrier(xb);
    { PV(); const float* x = (const float*)ap_->in[0]; const float* norm_ffn = (const float*)ap_->in[6]; float* mod = (float*)(ws + WS_MOD); float* mod0 = mod; bf16* W_GOUT_T = (bf16*)(ws + WS_W_GOUT); float* XR = (float*)(ws + WS_XR); bf16* H = (bf16*)(ws + WS_C); bf16* OG = H;
    { pg8::Gemm g{OG, W_GOUT_T, M, 2048, 2048}; pg8::StaticOrder S; S.init(M, 2048, G, (int)blockIdx.x); pg8::EpiRes<false, true> E{x, (bf16*)(ws + WS_XR), mod0 + 2 * 2048, nullptr};
      pg8::gemm_phase<pg8::EpiRes<false, true>, pg8::StaticOrder, true, true>(lds, g, S, E); }
    }
    xcd_barrier(xb);
    { PV(); const float* norm_ffn = (const float*)ap_->in[6]; float* mod = (float*)(ws + WS_MOD); float* mod0 = mod; float* XR = (float*)(ws + WS_XR); bf16* H = (bf16*)(ws + WS_C); bf16* PROJ = (bf16*)(ws + WS_A); bf16* ACT = PROJ;
    for (int row = ROW0(1), rend_ = ROWEND(row), rstep_ = ROWSTEP(1); row < rend_; row += rstep_) { const int b = row >> 12;
        modulate_pair((const bf16*)(ws + WS_XR), row, lane, norm_ffn, mod0 + (size_t)b * 12288 + 3 * 2048, mod0 + (size_t)b * 12288 + 4 * 2048, H, nullptr, nullptr, nullptr, nullptr); }
    }
    xcd_barrier(xb);
#ifndef REP_P7
#define REP_P7 1
#endif
    for (int rep_ = 0; rep_ < REP_P7; ++rep_) {
    { PV(); bf16* W_GU_T = (bf16*)(ws + WS_W_GU); float* XR = (float*)(ws + WS_XR); bf16* H = (bf16*)(ws + WS_C); bf16* PROJ = (bf16*)(ws + WS_A); bf16* ACT = PROJ;
    { pg8::Gemm g{H, W_GU_T, M, 2 * DFF, 2048}; pg8::StaticOrder S; S.init(M, 2 * DFF, G, (int)blockIdx.x); pg8::EpiSwiglu E{ACT, DFF};
      pg8::gemm_phase<pg8::EpiSwiglu, pg8::StaticOrder, true, true>(lds, g, S, E); }
    }
    xcd_barrier(xb);
    }
    { PV(); const float* norm_mix = (const float*)ap_->in[5]; const float* kv_norm = (const float*)ap_->in[19]; float* mod = (float*)(ws + WS_MOD); float* mod0 = mod; bf16* W_DN_T = (bf16*)(ws + WS_W_DN); float* XR = (float*)(ws + WS_XR); bf16* H = (bf16*)(ws + WS_C); bf16* GLAO = (bf16*)(ws + WS_B); bf16* HKV = GLAO; bf16* PROJ = (bf16*)(ws + WS_A); bf16* ACT = PROJ;
    { pg8::Gemm g{ACT, W_DN_T, M, 2048, DFF}; pg8::StaticOrder S; S.init(M, 2048, G, (int)blockIdx.x); pg8::EpiRes<true, true> E{(bf16*)(ws + WS_XR), (bf16*)(ws + WS_XR + 64 * MiB), mod0 + 5 * 2048, (float*)(ws + WS_PS)};
      pg8::gemm_phase<pg8::EpiRes<true, true>, pg8::StaticOrder, true, true>(lds, g, S, E); }
    }
    xcd_barrier(xb);
    { PV(); const float* norm_mix = (const float*)ap_->in[5]; const float* mla_w_dq = (const float*)ap_->in[12]; const float* mla_w_uq = (const float*)ap_->in[14]; const float* mla_w_out = (const float*)ap_->in[16]; const float* kv_norm = (const float*)ap_->in[19]; const float* kv_w_dkv = (const float*)ap_->in[20]; const float* kv_w_ukv = (const float*)ap_->in[22]; const float* ffn_w_gu = (const float*)ap_->in[24]; const float* ffn_w_down = (const float*)ap_->in[25]; float* mod = (float*)(ws + WS_MOD); float* mod1 = mod + 49152; float* modkv = mod + 98304; bf16* W_GU_T = (bf16*)(ws + WS_W_GU); bf16* W_DN_T = (bf16*)(ws + WS_W_DN); bf16* W_DKV_T = (bf16*)(ws + WS_W_DKV); bf16* W_DQ_T = (bf16*)(ws + WS_W_DQ); bf16* W_UKV_T = (bf16*)(ws + WS_W_UKV); bf16* W_UQ_T = (bf16*)(ws + WS_W_UQ); bf16* W_MOUT_T = (bf16*)(ws + WS_W_MOUT); float* XR = (float*)(ws + WS_XR); bf16* H = (bf16*)(ws + WS_C); bf16* GLAO = (bf16*)(ws + WS_B); bf16* HKV = GLAO; float* CKV = (float*)(ws + WS_CKV); float* CQ = (float*)(ws + WS_CQ);
    {
        for (int row = gt; row < M; row += NT) ((float*)(ws + WS_RSTD))[row] = pg8::row_rstd_ps((const float*)(ws + WS_PS), (size_t)row);
        __syncthreads();
        LAS float* scr = (LAS float*)(lds + wave * 16384);
        constexpr int I_DKV = 4 * 32 * 18, I_DQ = 4 * 32 * 16;
        for (int it = gw; it < I_DKV + I_DQ; it += NGW) {
            int r = it;
            if (r < I_DKV) { const int bb = r / 576, rr = r % 576, kb = rr / 18, nb = rr % 18;
                transpose_item(kv_w_dkv, 2048, 576, 32 * nb, W_DKV_T + (size_t)bb * 1280 * 2048, 32 * nb, 64 * kb, scr, lane, 1, kv_norm, modkv + (size_t)bb * 4096 + 2048); continue; } r -= I_DKV;
            { const int bb = r / 512, rr = r % 512, kb = rr / 16, nb = rr % 16;
                transpose_item(mla_w_dq, 2048, 512, 32 * nb, W_DKV_T + (size_t)bb * 1280 * 2048, 768 + 32 * nb, 64 * kb, scr, lane, 1, norm_mix + 2048, mod1 + (size_t)bb * 12288 + 2048); }
        }
        for (int i = gt; i < 4 * 49152; i += NT) { const int bb = i / 49152, off = i % 49152; ((v4u*)(W_DKV_T + ((size_t)bb * 1280 + 576) * 2048))[off] = (v4u){0u, 0u, 0u, 0u}; }
        { LAS float* red = (LAS float*)(lds + 131072); float* BP = (float*)(ws + WS_BP);
          for (int item = blockIdx.x; item < 136; item += G) { const int cg = item >> 2, kq = item & 3, c = tid & 31, ks = tid >> 5;
              const bool isk = cg < 18; const float* Wp = isk ? kv_w_dkv + 32 * cg + c : mla_w_dq + 32 * (cg - 18) + c; const int Nw = isk ? 576 : 512;
              const float* sh = isk ? modkv : mod1; const int shs = isk ? 4096 : 12288;
              float a0 = 0.f, a1 = 0.f, a2 = 0.f, a3 = 0.f;
#pragma unroll 8
              for (int kk = 0; kk < 32; ++kk) { const int k = 512 * kq + 32 * ks + kk; const float wv = Wp[(size_t)k * Nw];
                  a0 += sh[k] * wv; a1 += sh[shs + k] * wv; a2 += sh[2 * shs + k] * wv; a3 += sh[3 * shs + k] * wv; }
              __syncthreads();
              red[(ks * 4 + 0) * 32 + c] = a0; red[(ks * 4 + 1) * 32 + c] = a1; red[(ks * 4 + 2) * 32 + c] = a2; red[(ks * 4 + 3) * 32 + c] = a3;
              __syncthreads();
              if (tid < 128) { const int bb = tid >> 5; float sacc = 0.f;
#pragma unroll
                  for (int k2 = 0; k2 < 16; ++k2) sacc += red[(k2 * 4 + bb) * 32 + c];
                  BP[(size_t)(kq * 4 + bb) * 1280 + (isk ? 32 * cg : 768 + 32 * (cg - 18)) + c] = sacc; } } }
    }
    }
    xcd_barrier(xb);
    { PV(); float* KPE = (float*)(ws + WS_KPE); bf16* W_DKV_T = (bf16*)(ws + WS_W_DKV); bf16* W_DQ_T = (bf16*)(ws + WS_W_DQ); bf16* H = (bf16*)(ws + WS_C); bf16* GLAO = (bf16*)(ws + WS_B); bf16* HKV = GLAO; float* CKV = (float*)(ws + WS_CKV); float* CQ = (float*)(ws + WS_CQ); bf16* CLAT = (bf16*)(ws + WS_CLAT); bf16* CQN = (bf16*)(ws + WS_CQN);
    { pg8::Gemm g{(bf16*)(ws + WS_XR + 64 * MiB), W_DKV_T, M, 1280, 2048}; pg8::OrderFold S; S.o.init(M, 1280, G, (int)blockIdx.x); pg8::EpiFold E{(bf16*)CKV, (bf16*)CQ, (const float*)(ws + WS_BP), (const float*)(ws + WS_RSTD)};
      pg8::gemm_phase<pg8::EpiFold, pg8::OrderFold, true, true>(lds, g, S, E); }
    { const int nsingle = (G == 256) ? 192 : G, wi_ = (G == 256) ? (int)blockIdx.x - 64 : (int)blockIdx.x;
      if (wi_ >= 0) {
        const float* kv_w_ukv = (const float*)ap_->in[22]; const float* mla_w_uq = (const float*)ap_->in[14]; const float* mla_w_out = (const float*)ap_->in[16];
        const float* ffn_w_gu = (const float*)ap_->in[24]; const float* ffn_w_down = (const float*)ap_->in[25];
        bf16* W_UKV_T = (bf16*)(ws + WS_W_UKV); bf16* W_UQ_T = (bf16*)(ws + WS_W_UQ); bf16* W_MOUT_T = (bf16*)(ws + WS_W_MOUT); bf16* W_GU_T = (bf16*)(ws + WS_W_GU); bf16* W_DN_T = (bf16*)(ws + WS_W_DN);
        LAS float* scr = (LAS float*)(lds + wave * 16384);
        constexpr int I_UKV = 8 * 128, I_UQ = 8 * 96, I_MOUT = 32 * 64, I_GU = 32 * 352, I_DN = 88 * 64;
        for (int it = wi_ * 8 + wave; it < I_UKV + I_UQ + I_MOUT + I_GU + I_DN; it += nsingle * 8) {
            int r = it;
            if (r < I_UKV) { const int kb = r / 128, nb = r % 128; transpose_item(kv_w_ukv, 512, 4096, 32 * nb, W_UKV_T, 32 * nb, 64 * kb, scr, lane); continue; } r -= I_UKV;
            if (r < I_UQ) { const int kb = r / 96, nb = r % 96, hq = nb / 6, wi = nb % 6;
                transpose_item(mla_w_uq, 512, 3072, 32 * nb, W_UQ_T, 256 * hq + (wi < 4 ? 32 * wi : 128 + (wi - 4)), 64 * kb, scr, lane, wi < 4 ? 1 : 2); continue; } r -= I_UQ;
            if (r < I_MOUT) { const int kb = r / 64, nb = r % 64; transpose_item(mla_w_out, 2048, 2048, 32 * nb, W_MOUT_T, 32 * nb, 64 * kb, scr, lane); continue; } r -= I_MOUT;
            if (r < I_GU) { const int kb = r / 352, nb = r % 352; transpose_item(ffn_w_gu + (size_t)2048 * 2 * DFF, 2048, 2 * DFF, 32 * nb, W_GU_T, gu_row(32 * nb), 64 * kb, scr, lane); continue; } r -= I_GU;
            { const int kb = r / 64, nb = r % 64; transpose_item(ffn_w_down + (size_t)DFF * 2048, DFF, 2048, 32 * nb, W_DN_T, 32 * nb, 64 * kb, scr, lane); }
        }
        for (int i = wi_ * 512 + tid; i < 65536; i += nsingle * 512) { const int hq = i >> 12, off = i & 4095; ((v4u*)(W_UQ_T + ((size_t)hq * 256 + 192) * 512))[off] = (v4u){0u, 0u, 0u, 0u}; }
      } }
    }
    xcd_barrier(xb);
    { PV(); const int* positions = (const int*)ap_->in[2]; const float* mla_q_lat_norm = (const float*)ap_->in[13]; const float* kv_lat_norm = (const float*)ap_->in[21]; float* KPE = (float*)(ws + WS_KPE); float* KSS = (float*)(ws + WS_KSS); bf16* GLAO = (bf16*)(ws + WS_B); bf16* QRAW = GLAO; bf16* PROJ = (bf16*)(ws + WS_A); bf16* KVRAW = PROJ; float* CKV = (float*)(ws + WS_CKV); float* CQ = (float*)(ws + WS_CQ); bf16* CLAT = (bf16*)(ws + WS_CLAT); bf16* CQN = (bf16*)(ws + WS_CQN);
    for (int row = ROW0(0), rend_ = ROWEND(row), rstep_ = ROWSTEP(0); row < rend_; row += rstep_) {
        { const v4u cw = ((const v4u*)((const bf16*)CKV + (size_t)row * 768))[lane]; const f32x4 a0 = {bflo(cw.x), bfhi(cw.x), bflo(cw.y), bfhi(cw.y)}, a1 = {bflo(cw.z), bfhi(cw.z), bflo(cw.w), bfhi(cw.w)};
          const float rstd = rsqrtf(wave_sum(dot4(a0, a0) + dot4(a1, a1)) * (1.f / 512.f) + EPS);
          const f32x4* ln = (const f32x4*)kv_lat_norm + 2 * lane; const f32x4 g0 = ln[0], g1 = ln[1];
          v4u o; o.x = pk2(a0.x * rstd * g0.x, a0.y * rstd * g0.y); o.y = pk2(a0.z * rstd * g0.z, a0.w * rstd * g0.w); o.z = pk2(a1.x * rstd * g1.x, a1.y * rstd * g1.y); o.w = pk2(a1.z * rstd * g1.z, a1.w * rstd * g1.w);
          ((v4u*)(CLAT + (size_t)row * 512))[lane] = o; }
        { const int i = lane & 31; const float x1 = bf2f(((const bf16*)CKV)[(size_t)row * 768 + 512 + i]), x2 = bf2f(((const bf16*)CKV)[(size_t)row * 768 + 544 + i]);
          double rev = (double)((float)positions[row] * (float)INVF[i]) * 0.15915494309189535; rev -= rint(rev);
          const float c = __builtin_amdgcn_cosf((float)rev), s = __builtin_amdgcn_sinf((float)rev);
          const float o1 = x1 * c - x2 * s, o2 = x2 * c + x1 * s;
          if (lane < 32) { KPE[(size_t)row * 64 + 2 * i] = o1; KPE[(size_t)row * 64 + 2 * i + 1] = o2; float* CS = (float*)(ws + WS_CS); CS[(size_t)row * 64 + i] = c; CS[(size_t)row * 64 + 32 + i] = s; }
          const float ss = wave_sum(lane < 32 ? o1 * o1 + o2 * o2 : 0.f);
          if (lane == 0) KSS[row] = ss; }
        { const v4u cw = ((const v4u*)((const bf16*)CQ + (size_t)row * 512))[lane]; const f32x4 a0 = {bflo(cw.x), bfhi(cw.x), bflo(cw.y), bfhi(cw.y)}, a1 = {bflo(cw.z), bfhi(cw.z), bflo(cw.w), bfhi(cw.w)};
          const float rstd = rsqrtf(wave_sum(dot4(a0, a0) + dot4(a1, a1)) * (1.f / 512.f) + EPS);
          const f32x4* ln = (const f32x4*)mla_q_lat_norm + 2 * lane; const f32x4 g0 = ln[0], g1 = ln[1];
          v4u o; o.x = pk2(a0.x * rstd * g0.x, a0.y * rstd * g0.y); o.y = pk2(a0.z * rstd * g0.z, a0.w * rstd * g0.w); o.z = pk2(a1.x * rstd * g1.x, a1.y * rstd * g1.y); o.w = pk2(a1.z * rstd * g1.z, a1.w * rstd * g1.w);
          ((v4u*)(CQN + (size_t)row * 512))[lane] = o; }
    }
    }
    xcd_barrier(xb);
    { PV(); bf16* W_UKV_T = (bf16*)(ws + WS_W_UKV); bf16* W_UQ_T = (bf16*)(ws + WS_W_UQ); bf16* GLAO = (bf16*)(ws + WS_B); bf16* QRAW = GLAO; bf16* PROJ = (bf16*)(ws + WS_A); bf16* KVRAW = PROJ; bf16* CLAT = (bf16*)(ws + WS_CLAT); bf16* CQN = (bf16*)(ws + WS_CQN); bf16* KN = (bf16*)(ws + WS_KN); bf16* VT = (bf16*)(ws + WS_VT);
    { pg8::Gemm g{CLAT, W_UKV_T, M, 4096, 512}; pg8::StaticOrder S; S.init(M, 4096, G, (int)blockIdx.x);
      pg8::EpiKV E{KN, VT, (const float*)(ws + WS_KSS), (const float*)(ws + WS_KPE), (const float*)ap_->in[23], (LAS float*)(lds + 131072)};
      pg8::gemm_phase<pg8::EpiKV, pg8::StaticOrder, true, true>(lds, g, S, E); }
    { pg8::Gemm g{CQN, W_UQ_T, M, 4096, 512}; pg8::StaticOrder S; S.init(M, 4096, G, (int)blockIdx.x);
      pg8::EpiQ E{QRAW, (const float*)(ws + WS_CS), (const float*)ap_->in[15], QSCALE, (LAS float*)(lds + 131072)};
      pg8::gemm_phase<pg8::EpiQ, pg8::StaticOrder, true, true>(lds, g, S, E); }
    }
    xcd_barrier(xb);
#ifndef REP_ATTN
#define REP_ATTN 1
#endif
    for (int rep_ = 0; rep_ < REP_ATTN; ++rep_) {
    { PV(); const float* mla_w_out = (const float*)ap_->in[16]; float* XR = (float*)(ws + WS_XR); bf16* H = (bf16*)(ws + WS_C); bf16* AO = H; bf16* GLAO = (bf16*)(ws + WS_B); bf16* QRAW = GLAO; bf16* KN = (bf16*)(ws + WS_KN); bf16* VT = (bf16*)(ws + WS_VT);
    for (int pr = vcu; pr < 512; pr += G) {
        const int bh = pr >> 3, s = pr & 7, b = bh >> 4, h = bh & 15;
#pragma unroll 1
        for (int u2 = 0; u2 < 2; ++u2) attn_unit(b, h, u2 ? 15 - s : s, QRAW, KN, VT, AO, lds, tid);
    }
    }
    xcd_barrier(xb);
    }
    { PV(); const float* norm_ffn = (const float*)ap_->in[6]; float* mod = (float*)(ws + WS_MOD); float* mod1 = mod + 49152; bf16* W_MOUT_T = (bf16*)(ws + WS_W_MOUT); float* XR = (float*)(ws + WS_XR); bf16* H = (bf16*)(ws + WS_C); bf16* AO = H;
    { pg8::Gemm g{AO, W_MOUT_T, M, 2048, 2048}; pg8::StaticOrder S; S.init(M, 2048, G, (int)blockIdx.x); pg8::EpiRes<true, true> E{(bf16*)(ws + WS_XR + 64 * MiB), (bf16*)(ws + WS_XR), mod1 + 2 * 2048, nullptr};
      pg8::gemm_phase<pg8::EpiRes<true, true>, pg8::StaticOrder, true, true>(lds, g, S, E); }
    }
    xcd_barrier(xb);
    { PV(); const float* norm_ffn = (const float*)ap_->in[6]; float* mod = (float*)(ws + WS_MOD); float* mod1 = mod + 49152; float* XR = (float*)(ws + WS_XR); bf16* H = (bf16*)(ws + WS_C);
    for (int row = ROW0(1), rend_ = ROWEND(row), rstep_ = ROWSTEP(1); row < rend_; row += rstep_) { const int b = row >> 12;
        modulate_pair((const bf16*)(ws + WS_XR), row, lane, norm_ffn + 2048, mod1 + (size_t)b * 12288 + 3 * 2048, mod1 + (size_t)b * 12288 + 4 * 2048, H, nullptr, nullptr, nullptr, nullptr); }
    }
    xcd_barrier(xb);
    { PV(); float* mod = (float*)(ws + WS_MOD); float* mod1 = mod + 49152; bf16* W_GU_T = (bf16*)(ws + WS_W_GU); bf16* W_DN_T = (bf16*)(ws + WS_W_DN); float* XR = (float*)(ws + WS_XR); bf16* H = (bf16*)(ws + WS_C); bf16* PROJ = (bf16*)(ws + WS_A); bf16* ACT = PROJ;
    { pg8::Gemm g{H, W_GU_T, M, 2 * DFF, 2048}; pg8::StaticOrder S; S.init(M, 2 * DFF, G, (int)blockIdx.x); pg8::EpiSwiglu E{ACT, DFF};
      pg8::gemm_phase<pg8::EpiSwiglu, pg8::StaticOrder, true, true>(lds, g, S, E); }
    }
    xcd_barrier(xb);
    { PV(); float* mod = (float*)(ws + WS_MOD); float* mod1 = mod + 49152; bf16* W_DN_T = (bf16*)(ws + WS_W_DN); float* XR = (float*)(ws + WS_XR); bf16* ACT = (bf16*)(ws + WS_A);
    { pg8::Gemm g{ACT, W_DN_T, M, 2048, DFF}; pg8::StaticOrder S; S.init(M, 2048, G, (int)blockIdx.x); pg8::EpiRes<true, false> E{(bf16*)(ws + WS_XR), ap_->out, mod1 + 5 * 2048, nullptr};
      pg8::gemm_phase<pg8::EpiRes<true, false>, pg8::StaticOrder, true, true>(lds, g, S, E); }
    }
}

extern "C" void kernel_launch(void* const* d_in, const int* in_sizes, int n_in, void* d_out, int out_size, void* d_ws, size_t ws_size, hipStream_t stream) {
    static int grid = 0;
    if (grid == 0) {
        if (n_in != 26 || out_size != M * DM || ws_size < WS_END) { fprintf(stderr, "kernel_launch: unexpected shapes (n_in %d out %d ws %zu)\n", n_in, out_size, ws_size); grid = -1; return; }
        int dev = 0, cus = 0, per_cu = 0;
        (void)hipGetDevice(&dev); (void)hipDeviceGetAttribute(&cus, hipDeviceAttributeMultiprocessorCount, dev);
        (void)hipFuncSetAttribute((const void*)fwd, hipFuncAttributeMaxDynamicSharedMemorySize, LDS_BYTES);
        (void)hipOccupancyMaxActiveBlocksPerMultiprocessor(&per_cu, (const void*)fwd, 512, LDS_BYTES);
        if (per_cu < 1) per_cu = 1;
        grid = cus * per_cu;
    }
    if (grid < 0) return;
    Args a{};
    for (int i = 0; i < 26; ++i) a.in[i] = d_in[i];
    a.out = (float*)d_out; a.ws = (unsigned char*)d_ws;
    void* args[] = {&a};
    hipError_t e = hipLaunchCooperativeKernel((const void*)fwd, dim3(grid), dim3(512), args, LDS_BYTES, stream);
    if (e != hipSuccess) fprintf(stderr, "cooperative launch failed: %s (grid %d)\n", hipGetErrorString(e), grid);
}
```
